# Optimizing an MI355X kernel written in HIP

```python
import jax, jax.numpy as jnp
from jax import lax
import numpy as np

D_MODEL = 1024
BATCH = 2
SEQ = 8192
DEPTH = 2
DEC_BATCH = 128
DEC_SEQ = 4
PAST_LEN = 2048
PAGE_SIZE = 128

N_MIXERS = 2
RET_HEADS = 4
RET_DK = 256
RET_DV = 512
RET_CHUNK = 128
ATT_GROUPS = ((128, 1), (512, 4), (2048, 16))
N_GROUPS = len(ATT_GROUPS)
ATT_HEADS_PER_GROUP = 8
ATT_HEAD_DIM = 64
ATT_HEADS = N_GROUPS * ATT_HEADS_PER_GROUP
D_FF = 2816
ALPHA = (2 * DEPTH) ** 0.25
BETA = (8 * DEPTH) ** -0.25
NORM_EPS = 1e-5

kernel_name = "hybrid_retention_dilated_macaron_step"


def layer_norm(x, g, b):
    xf = x.astype(jnp.float32)
    mu = jnp.mean(xf, -1, keepdims=True)
    var = jnp.mean(jnp.square(xf - mu), -1, keepdims=True)
    return ((xf - mu) * lax.rsqrt(var + NORM_EPS) * g + b).astype(x.dtype)


def swiglu(u, w_in, w_out):
    a, b = jnp.split(u @ w_in, 2, axis=-1)
    return (jax.nn.silu(a) * b) @ w_out


def retention_log_gamma():
    return jnp.log1p(-(2.0 ** (-5.0 - jnp.arange(RET_HEADS, dtype=jnp.float32))))


def alibi_slopes():
    h = jnp.arange(1, ATT_HEADS + 1, dtype=jnp.float32)
    return (2.0 ** (-8.0 * h / ATT_HEADS)).reshape(N_GROUPS, ATT_HEADS_PER_GROUP)


def retention_scan(q, k, v, s0, chunk):
    n, l, h, _ = q.shape
    nc = l // chunk

    def split(t):
        return t.reshape(n, nc, chunk, h, t.shape[-1]).transpose(1, 0, 2, 3, 4)

    log_g = retention_log_gamma()
    pos = jnp.arange(chunk, dtype=jnp.float32)
    diff = pos[:, None] - pos[None, :]
    causal = diff >= 0
    inner_decay = jnp.where(causal, jnp.exp(jnp.where(causal, diff, 0.0) * log_g[:, None, None]), 0.0)
    q_decay = jnp.exp((pos[:, None] + 1.0) * log_g)
    k_decay = jnp.exp((chunk - 1.0 - pos[:, None]) * log_g)
    chunk_decay = jnp.exp(chunk * log_g)

    def step(s, qkv):
        qc, kc, vc = qkv
        scores = jnp.einsum('nqhd,nkhd->nhqk', qc, kc) * inner_decay
        o = (jnp.einsum('nhqk,nkhe->nqhe', scores, vc)
             + jnp.einsum('nqhd,nhde->nqhe', qc, s) * q_decay[None, :, :, None])
        s = (s * chunk_decay[None, :, None, None]
             + jnp.einsum('nkhd,nkhe->nhde', kc * k_decay[None, :, :, None], vc))
        return s, o

    s_final, o = lax.scan(step, s0, (split(q), split(k), split(v)))
    o = o.transpose(1, 0, 2, 3, 4).reshape(n, l, h, v.shape[-1])
    return o, s_final


def retention_mixer(u, w_in, gn_g, gn_b, w_out, s0, chunk):
    n, l, _ = u.shape
    qk_w = RET_HEADS * RET_DK
    v_w = RET_HEADS * RET_DV
    q, k, v, g = jnp.split(u @ w_in, [qk_w, 2 * qk_w, 2 * qk_w + v_w], axis=-1)
    f32 = jnp.float32
    q = q.reshape(n, l, RET_HEADS, RET_DK).astype(f32)
    k = k.reshape(n, l, RET_HEADS, RET_DK).astype(f32) * (RET_DK ** -0.5)
    v = v.reshape(n, l, RET_HEADS, RET_DV).astype(f32)
    o, s_new = retention_scan(q, k, v, s0.astype(f32), chunk)
    mu = jnp.mean(o, -1, keepdims=True)
    var = jnp.mean(jnp.square(o - mu), -1, keepdims=True)
    o = ((o - mu) * lax.rsqrt(var + NORM_EPS)).reshape(n, l, v_w) * gn_g + gn_b
    y = (jax.nn.silu(g) * o.astype(u.dtype)) @ w_out
    return y, s_new.astype(u.dtype)


def softmax_with_lse(s, valid):
    s = jnp.where(valid, s, -jnp.inf)
    m = jnp.max(s, -1, keepdims=True)
    e = jnp.exp(s - m)
    den = jnp.sum(e, -1, keepdims=True)
    return e / den, (m + jnp.log(den))[..., 0]


def banded_dilated_attention(q, k, v, dil, nback, slopes):
    n, s_len, h, dh = q.shape
    L = s_len // dil
    nn = n * dil

    def to_classes(t):
        return t.reshape(n, L, dil, h, dh).transpose(0, 2, 1, 3, 4).reshape(nn, L, h, dh)

    qr, kr, vr = to_classes(q), to_classes(k), to_classes(v)
    blk = nback
    nb = -(-L // blk)
    lp = nb * blk
    qb = jnp.pad(qr, ((0, 0), (0, lp - L), (0, 0), (0, 0))).reshape(nn, nb, blk, h, dh)

    def windows(t):
        tp = jnp.pad(t, ((0, 0), (blk, lp - L), (0, 0), (0, 0))).reshape(nn, nb + 1, blk, h, dh)
        return jnp.concatenate([tp[:, :-1], tp[:, 1:]], axis=2)

    kw, vw = windows(kr), windows(vr)
    steps = blk + jnp.arange(blk)[:, None] - jnp.arange(2 * blk)[None, :]
    kpos = jnp.arange(nb)[:, None] * blk + jnp.arange(2 * blk)[None, :] - blk
    valid = ((steps >= 0) & (steps <= nback))[None] & (kpos >= 0)[:, None, :]
    scores = jnp.einsum('nbqhd,nbkhd->nbhqk', qb, kw).astype(jnp.float32) * (dh ** -0.5)
    scores = scores - (slopes * dil)[:, None, None] * steps.astype(jnp.float32)
    p, lse = softmax_with_lse(scores, valid[None, :, None])
    o = jnp.einsum('nbhqk,nbkhd->nbqhd', p.astype(vw.dtype), vw).reshape(nn, lp, h, dh)[:, :L]
    lse = lse.transpose(0, 1, 3, 2).reshape(nn, lp, h)[:, :L]
    o = o.reshape(n, dil, L, h, dh).transpose(0, 2, 1, 3, 4).reshape(n, s_len, h, dh)
    lse = lse.reshape(n, dil, L, h).transpose(0, 2, 1, 3).reshape(n, s_len, h)
    return o, lse


def gathered_dilated_attention(q, k_new, v_new, kv_buf, dil, nback, slopes):
    n, t, h, dh = q.shape
    lb = kv_buf.shape[1]
    k_all = jnp.concatenate([kv_buf[:, :, 0], k_new], axis=1)
    v_all = jnp.concatenate([kv_buf[:, :, 1], v_new], axis=1)
    j = jnp.arange(nback + 1)
    idx = lb + jnp.arange(t)[:, None] - j[None, :] * dil
    valid = idx >= 0
    idx = jnp.maximum(idx, 0)
    kg = k_all[:, idx]
    vg = v_all[:, idx]
    scores = jnp.einsum('nqhd,nqkhd->nhqk', q, kg).astype(jnp.float32) * (dh ** -0.5)
    scores = scores - (slopes * dil)[:, None, None] * j.astype(jnp.float32)
    p, lse = softmax_with_lse(scores, valid[None, None])
    o = jnp.einsum('nhqk,nqkhd->nqhd', p.astype(vg.dtype), vg)
    return o, lse.transpose(0, 2, 1)


def dilated_mixer(u, w_in, w_out, kv_bufs):
    n, l, _ = u.shape
    qkv = (u @ w_in).reshape(n, l, 3, N_GROUPS, ATT_HEADS_PER_GROUP, ATT_HEAD_DIM)
    slopes = alibi_slopes()
    outs, lses, new_kv = [], [], []
    for g, (window, dil) in enumerate(ATT_GROUPS):
        nback = window // dil
        qg, kg, vg = qkv[:, :, 0, g], qkv[:, :, 1, g], qkv[:, :, 2, g]
        if kv_bufs is None:
            o, lse = banded_dilated_attention(qg, kg, vg, dil, nback, slopes[g])
            keep = min(window, l)
            new_kv.append(jnp.stack([kg[:, l - keep:], vg[:, l - keep:]], axis=2))
        else:
            o, lse = gathered_dilated_attention(qg, kg, vg, kv_bufs[g], dil, nback, slopes[g])
            new_kv.append(jnp.stack([kg, vg], axis=2))
        outs.append(o)
        lses.append(lse)
    alpha = jax.nn.softmax(jnp.stack(lses, 0), axis=0)
    o = jnp.einsum('gnsh,gnshd->nshd', alpha, jnp.stack(outs, 0).astype(jnp.float32))
    y = o.reshape(n, l, ATT_HEADS_PER_GROUP * ATT_HEAD_DIM).astype(u.dtype) @ w_out
    return y, new_kv


def run_trunk(x, c, ret_state, kv_bufs, ret_chunk, w_ada, b_ada, ln_g, ln_b, w_ffn_in, w_ffn_out,
              w_ret_in, ret_gn_g, ret_gn_b, w_ret_out, w_att_in, w_att_out):
    n = x.shape[0]
    ret_new, kv_new = None, None
    for i in range(DEPTH):
        ada = (jax.nn.silu(c) @ w_ada[i] + b_ada[i]).reshape(n, 1, 3, 3, D_MODEL)

        def modulate(h, j):
            return h * (1.0 + ada[:, :, j, 1]) + ada[:, :, j, 0]

        h = swiglu(modulate(x, 0), w_ffn_in[i, 0], w_ffn_out[i, 0])
        x = layer_norm(ALPHA * x + 0.5 * (1.0 + ada[:, :, 0, 2]) * h, ln_g[i, 0], ln_b[i, 0])
        if i % N_MIXERS == 0:
            mix, ret_new = retention_mixer(modulate(x, 1), w_ret_in, ret_gn_g, ret_gn_b, w_ret_out,
                                           ret_state, ret_chunk)
        else:
            mix, kv_new = dilated_mixer(modulate(x, 1), w_att_in, w_att_out, kv_bufs)
        x = layer_norm(ALPHA * x + (1.0 + ada[:, :, 1, 2]) * mix, ln_g[i, 1], ln_b[i, 1])
        h = swiglu(modulate(x, 2), w_ffn_in[i, 1], w_ffn_out[i, 1])
        x = layer_norm(ALPHA * x + 0.5 * (1.0 + ada[:, :, 2, 2]) * h, ln_g[i, 2], ln_b[i, 2])
    return x, ret_new, kv_new


def setup_inputs(seed: int = 0) -> dict:
    key = jax.random.key(seed)
    ks = jax.random.split(key, 24)
    f32 = jnp.float32
    d = D_MODEL

    def nrm(k, shape, scale):
        return jax.random.normal(k, shape, f32) * scale

    ret_in_w = RET_HEADS * (2 * RET_DK + 2 * RET_DV)
    ret_v_w = RET_HEADS * RET_DV
    att_in_w = 3 * ATT_HEADS * ATT_HEAD_DIM
    att_out_w = ATT_HEADS_PER_GROUP * ATT_HEAD_DIM
    kv_shape = lambda w: (DEC_BATCH, min(w, PAST_LEN), 2, ATT_HEADS_PER_GROUP, ATT_HEAD_DIM)
    return {
        "x_prompt": nrm(ks[0], (BATCH, SEQ, d), 1.0),
        "x_sample": nrm(ks[1], (DEC_BATCH, DEC_SEQ, d), 1.0),
        "c_prompt": nrm(ks[2], (BATCH, d), 1.0),
        "c_sample": nrm(ks[3], (DEC_BATCH, d), 1.0),
        "state_ret": nrm(ks[4], (DEC_BATCH, RET_HEADS, RET_DK, RET_DV), 0.5),
        "cache_kv_w128": nrm(ks[5], kv_shape(ATT_GROUPS[0][0]), 1.0),
        "cache_kv_w512": nrm(ks[6], kv_shape(ATT_GROUPS[1][0]), 1.0),
        "cache_kv_w2048": nrm(ks[7], kv_shape(ATT_GROUPS[2][0]), 1.0),
        "w_ada": nrm(ks[8], (DEPTH, d, 9 * d), 0.2 * d ** -0.5),
        "b_ada": nrm(ks[9], (DEPTH, 9 * d), 0.01),
        "ln_g": 1.0 + nrm(ks[10], (DEPTH, 3, d), 0.02),
        "ln_b": nrm(ks[11], (DEPTH, 3, d), 0.01),
        "w_ffn_in": nrm(ks[12], (DEPTH, 2, d, 2 * D_FF), d ** -0.5),
        "w_ffn_out": nrm(ks[13], (DEPTH, 2, D_FF, d), BETA * D_FF ** -0.5),
        "w_ret_in": nrm(ks[14], (d, ret_in_w), d ** -0.5),
        "ret_gn_g": 1.0 + nrm(ks[15], (ret_v_w,), 0.02),
        "ret_gn_b": nrm(ks[16], (ret_v_w,), 0.01),
        "w_ret_out": nrm(ks[17], (ret_v_w, d), BETA * ret_v_w ** -0.5),
        "w_att_in": nrm(ks[18], (d, att_in_w), d ** -0.5),
        "w_att_out": nrm(ks[19], (att_out_w, d), BETA * att_out_w ** -0.5),
    }


def reference(x_prompt, x_sample, c_prompt, c_sample, state_ret, cache_kv_w128, cache_kv_w512,
              cache_kv_w2048, w_ada, b_ada, ln_g, ln_b, w_ffn_in, w_ffn_out, w_ret_in, ret_gn_g,
              ret_gn_b, w_ret_out, w_att_in, w_att_out):
    s0_prompt = jnp.zeros((x_prompt.shape[0], RET_HEADS, RET_DK, RET_DV), x_prompt.dtype)
    y_prompt, ret_p, kv_p = run_trunk(
        x_prompt, c_prompt, s0_prompt, None, RET_CHUNK, w_ada, b_ada, ln_g, ln_b, w_ffn_in,
        w_ffn_out, w_ret_in, ret_gn_g, ret_gn_b, w_ret_out, w_att_in, w_att_out)
    y_sample, ret_s, kv_s = run_trunk(
        x_sample, c_sample, state_ret, (cache_kv_w128, cache_kv_w512, cache_kv_w2048),
        x_sample.shape[1], w_ada, b_ada, ln_g, ln_b, w_ffn_in, w_ffn_out, w_ret_in, ret_gn_g,
        ret_gn_b, w_ret_out, w_att_in, w_att_out)
    return (y_prompt, y_sample, ret_p, ret_s, kv_p[0], kv_s[0], kv_p[1], kv_s[1], kv_p[2], kv_s[2])
```

```cpp
#ifndef HOST_SIM
#include <hip/hip_runtime.h>
#include <cstdio>
#include <cstdint>
#define HD __host__ __device__ __forceinline__
#else
#include <cmath>
#include <cstdio>
#include <cstdint>
#include <cstring>
#define HD inline
#endif

#ifndef CFG_D
#define CFG_D 1024
#define CFG_FF 2816
#define CFG_BATCH 2
#define CFG_SEQ 8192
#define CFG_DB 128
#define CFG_DS 4
#define CFG_PAST 2048
#define CFG_RH 4
#define CFG_RDK 256
#define CFG_RDV 512
#define CFG_RC 256
#define CFG_AH 8
#define CFG_AD 64
#define CFG_W0 128
#define CFG_DIL0 1
#define CFG_W1 512
#define CFG_DIL1 4
#define CFG_W2 2048
#define CFG_DIL2 16
#endif
namespace cfg {
constexpr int D = CFG_D, FF = CFG_FF, NFF = 2 * CFG_FF, BATCH = CFG_BATCH, SEQ = CFG_SEQ, DB = CFG_DB, DS = CFG_DS, PAST = CFG_PAST;
constexpr int MP = BATCH * SEQ, MS = DB * DS, M = MP + MS, NSEQ = BATCH + DB;
constexpr int RH = CFG_RH, RDK = CFG_RDK, RDV = CFG_RDV, RC = CFG_RC, QKW = RH * RDK, VW = RH * RDV, NRET = 2 * QKW + 2 * VW;
constexpr int NSEG = SEQ / RC, NITEM = BATCH * RH * NSEG;
constexpr int AH = CFG_AH, AD = CFG_AD, AO = AH * AD, NG = 3, NATT = 3 * NG * AO;
constexpr int SCR = ((NSEQ + 255) / 256) * 256;
constexpr int ADA_LD = 18 * D;
constexpr float LN_EPS = 1e-5f;
constexpr float ALPHA = 1.41421356237309515f;
HD int win(int g) { return g == 0 ? CFG_W0 : (g == 1 ? CFG_W1 : CFG_W2); }
HD int dil(int g) { return g == 0 ? CFG_DIL0 : (g == 1 ? CFG_DIL1 : CFG_DIL2); }
HD int nback(int g) { return win(g) / dil(g); }
HD int lbuf(int g) { return win(g) < PAST ? win(g) : PAST; }
HD int keep(int g) { return win(g) < SEQ ? win(g) : SEQ; }
constexpr long O_YP = 0, O_YS = O_YP + (long)MP * D, O_SRP = O_YS + (long)MS * D, O_SRS = O_SRP + (long)BATCH * RH * RDK * RDV, O_KV0 = O_SRS + (long)DB * RH * RDK * RDV;
}

typedef unsigned short bf16;
HD unsigned f2bf_u(float f) { unsigned u = __builtin_bit_cast(unsigned, f); return (u + 0x7fffu + ((u >> 16) & 1u)) >> 16; }
HD bf16 f2bf(float f) { return (bf16)f2bf_u(f); }
HD float bf2f(bf16 h) { unsigned u = (unsigned)h << 16; return __builtin_bit_cast(float, u); }
HD float silu_f(float x) { return x / (1.0f + expf(-x)); }
HD float swiglu_f(float a, float b) { return silu_f(a) * b; }
HD int seq_of_row(int m) { return m < cfg::MP ? m / cfg::SEQ : cfg::BATCH + (m - cfg::MP) / cfg::DS; }
HD float ret_log_gamma(int h) { return log1pf(-exp2f(-5.0f - (float)h)); }
HD float ret_pow(int h, float n) { return expf(n * ret_log_gamma(h)); }
HD float alibi_slope(int g, int head) { return exp2f(-8.0f * (float)(g * cfg::AH + head + 1) / (float)(cfg::NG * cfg::AH)); }
HD int ffn_dst_of_src(int c) { const int half = c / cfg::FF, j = c % cfg::FF; return 256 * (j / 128) + 128 * half + (j % 128); }
HD int ffn_src_of_dst(int r) { const int p = r / 256, rr = r % 256, half = rr / 128; return half * cfg::FF + 128 * p + rr % 128; }

struct Ptrs {
    const float *x_prompt, *x_sample, *c_prompt, *c_sample, *state_ret, *cache0, *cache1, *cache2, *w_ada, *b_ada, *ln_g, *ln_b, *w_ffn_in, *w_ffn_out, *w_ret_in, *ret_gn_g, *ret_gn_b, *w_ret_out, *w_att_in, *w_att_out;
    float* out;
    unsigned* ctl;
    bf16 *wfi_t, *wfo_t, *wri_t, *wro_t, *wai_t, *wao_t, *wada_t;
    bf16 *sc;
    float *ada;
    float *X, *Y;
    bf16 *XN, *H, *QKV, *AOB, *OB;
    float *U, *SIN, *PS, *ORET, *OG, *LSE;
};

HD const float* cache_ptr(const Ptrs& p, int g) { const uintptr_t m0 = (uintptr_t)0 - (uintptr_t)(g == 0), m1 = (uintptr_t)0 - (uintptr_t)(g == 1), m2 = (uintptr_t)0 - (uintptr_t)(g == 2); return (const float*)(((uintptr_t)p.cache0 & m0) | ((uintptr_t)p.cache1 & m1) | ((uintptr_t)p.cache2 & m2)); }
HD void it_silu_c(const Ptrs& p, long i) {
    using namespace cfg; const int r = (int)(i / D), k = (int)(i % D); float v = 0.f;
    if (r < NSEQ) v = silu_f(r < BATCH ? p.c_prompt[(long)r * D + k] : p.c_sample[(long)(r - BATCH) * D + k]);
    p.sc[i] = f2bf(v);
}
HD const float* ada_vec(const Ptrs& p, int seq, int layer, int j, int which) { return p.ada + (size_t)seq * cfg::ADA_LD + layer * 9 * cfg::D + (j * 3 + which) * cfg::D; }
HD void it_mod0(const Ptrs& p, long i) {
    using namespace cfg; const int m = (int)(i / D), c = (int)(i % D);
    const float x = m < MP ? p.x_prompt[i] : p.x_sample[i - (long)MP * D];
    const int s = seq_of_row(m);
    p.X[i] = x; p.XN[i] = f2bf(x * (1.0f + ada_vec(p, s, 0, 0, 1)[c]) + ada_vec(p, s, 0, 0, 0)[c]);
}
HD void it_ln_row(const Ptrs& p, int m, int layer, int j, float coef, int nl, int nj) {
    using namespace cfg; const int s = seq_of_row(m); const float* gate = ada_vec(p, s, layer, j, 2);
    float* X = p.X + (size_t)m * D; const float* Y = p.Y + (size_t)m * D;
    const float* lg = p.ln_g + (size_t)(layer * 3 + j) * D; const float* lb = p.ln_b + (size_t)(layer * 3 + j) * D;
    float sum = 0.f; for (int c = 0; c < D; ++c) sum += ALPHA * X[c] + coef * (1.0f + gate[c]) * Y[c];
    const float mu = sum / (float)D; float sq = 0.f;
    for (int c = 0; c < D; ++c) { const float z = ALPHA * X[c] + coef * (1.0f + gate[c]) * Y[c] - mu; sq += z * z; }
    const float rstd = 1.0f / sqrtf(sq / (float)D + LN_EPS);
    if (nj >= 0) { const float* sh = ada_vec(p, s, nl, nj, 0); const float* sc = ada_vec(p, s, nl, nj, 1); bf16* XN = p.XN + (size_t)m * D;
        for (int c = 0; c < D; ++c) { const float z = ALPHA * X[c] + coef * (1.0f + gate[c]) * Y[c]; const float xn = (z - mu) * rstd * lg[c] + lb[c]; X[c] = xn; XN[c] = f2bf(xn * (1.0f + sc[c]) + sh[c]); } }
    else { float* o = p.out + (size_t)m * D;
        for (int c = 0; c < D; ++c) { const float z = ALPHA * X[c] + coef * (1.0f + gate[c]) * Y[c]; o[c] = (z - mu) * rstd * lg[c] + lb[c]; } }
}
HD void ret_item(int it, int& n, int& h, int& seg) { using namespace cfg; n = it / (RH * NSEG); h = (it / NSEG) % RH; seg = it % NSEG; }
HD void it_ret_local(const Ptrs& p, long i) {
    using namespace cfg; const int it = (int)(i / (RDK * RDV)), d = (int)(i / RDV) % RDK, e = (int)(i % RDV); int n, h, seg; ret_item(it, n, h, seg);
    const size_t m0 = (size_t)n * SEQ + (size_t)seg * RC; const float ks = 1.0f / sqrtf((float)RDK); float acc = 0.f;
    for (int s = 0; s < RC; ++s) { const bf16* row = p.QKV + (m0 + s) * NRET; acc += ret_pow(h, (float)(RC - 1 - s)) * ks * bf2f(row[QKW + h * RDK + d]) * bf2f(row[2 * QKW + h * RDV + e]); }
    p.U[i] = acc;
}
HD void it_ret_scan(const Ptrs& p, long i) {
    using namespace cfg; const int nh = (int)(i / (RDK * RDV)); const long de = i % (RDK * RDV); const int h = nh % RH; const float cd = ret_pow(h, (float)RC); float S = 0.f;
    for (int seg = 0; seg < NSEG; ++seg) { const size_t o = ((size_t)nh * NSEG + seg) * (RDK * RDV) + de; p.SIN[o] = S; S = cd * S + p.U[o]; }
    p.out[O_SRP + i] = S;
}
HD void it_ret_scores(const Ptrs& p, long i) {
    using namespace cfg; const int it = (int)(i / (RC * RC)), t = (int)(i / RC) % RC, s = (int)(i % RC); int n, h, seg; ret_item(it, n, h, seg);
    float v = 0.f;
    if (s <= t) { const size_t m0 = (size_t)n * SEQ + (size_t)seg * RC; const bf16* q = p.QKV + (m0 + t) * NRET + h * RDK; const bf16* k = p.QKV + (m0 + s) * NRET + QKW + h * RDK; float acc = 0.f;
        for (int d = 0; d < RDK; ++d) acc += bf2f(q[d]) * bf2f(k[d]);
        v = acc * (1.0f / sqrtf((float)RDK)) * ret_pow(h, (float)(t - s)); }
    p.PS[i] = v;
}
HD void it_ret_out(const Ptrs& p, long i) {
    using namespace cfg; const int it = (int)(i / (RC * RDV)), t = (int)(i / RDV) % RC, e = (int)(i % RDV); int n, h, seg; ret_item(it, n, h, seg);
    const size_t m0 = (size_t)n * SEQ + (size_t)seg * RC; const float* P = p.PS + ((size_t)it * RC + t) * RC; float acc = 0.f;
    for (int s = 0; s <= t; ++s) acc += P[s] * bf2f(p.QKV[(m0 + s) * NRET + 2 * QKW + h * RDV + e]);
    const bf16* q = p.QKV + (m0 + t) * NRET + h * RDK; const float* S = p.SIN + (size_t)it * (RDK * RDV) + e; float a2 = 0.f;
    for (int d = 0; d < RDK; ++d) a2 += bf2f(q[d]) * S[(size_t)d * RDV];
    p.ORET[(m0 + t) * VW + h * RDV + e] = acc + ret_pow(h, (float)(t + 1)) * a2;
}
HD void it_rets_state(const Ptrs& p, long i) {
    using namespace cfg; const int nh = (int)(i / (RDK * RDV)), n = nh / RH, h = nh % RH, d = (int)(i / RDV) % RDK, e = (int)(i % RDV);
    const float ks = 1.0f / sqrtf((float)RDK); float acc = ret_pow(h, (float)DS) * p.state_ret[i];
    for (int s = 0; s < DS; ++s) { const bf16* row = p.QKV + ((size_t)MP + (size_t)n * DS + s) * NRET; acc += ret_pow(h, (float)(DS - 1 - s)) * ks * bf2f(row[QKW + h * RDK + d]) * bf2f(row[2 * QKW + h * RDV + e]); }
    p.out[O_SRS + i] = acc;
}
HD void it_rets_out(const Ptrs& p, long i) {
    using namespace cfg; const int ms = (int)(i / (RH * RDV)), h = (int)(i / RDV) % RH, e = (int)(i % RDV), n = ms / DS, t = ms % DS;
    const size_t r0 = (size_t)MP + (size_t)n * DS; const bf16* q = p.QKV + (r0 + t) * NRET + h * RDK; const float ks = 1.0f / sqrtf((float)RDK); float acc = 0.f;
    for (int s = 0; s <= t; ++s) { const bf16* k = p.QKV + (r0 + s) * NRET + QKW + h * RDK; float qk = 0.f; for (int d = 0; d < RDK; ++d) qk += bf2f(q[d]) * bf2f(k[d]);
        acc += qk * ks * ret_pow(h, (float)(t - s)) * bf2f(p.QKV[(r0 + s) * NRET + 2 * QKW + h * RDV + e]); }
    const float* S = p.state_ret + ((size_t)n * RH + h) * (RDK * RDV) + e; float a2 = 0.f;
    for (int d = 0; d < RDK; ++d) a2 += bf2f(q[d]) * S[(size_t)d * RDV];
    p.ORET[(r0 + t) * VW + h * RDV + e] = acc + ret_pow(h, (float)(t + 1)) * a2;
}
HD void it_ret_gate(const Ptrs& p, long i) {
    using namespace cfg; const size_t m = (size_t)(i / RH); const int h = (int)(i % RH); const float* o = p.ORET + m * VW + h * RDV; float sum = 0.f;
    for (int e = 0; e < RDV; ++e) sum += o[e];
    const float mu = sum / (float)RDV; float sq = 0.f; for (int e = 0; e < RDV; ++e) { const float z = o[e] - mu; sq += z * z; }
    const float rstd = 1.0f / sqrtf(sq / (float)RDV + LN_EPS); const bf16* g = p.QKV + m * NRET + 2 * QKW + VW + h * RDV;
    for (int e = 0; e < RDV; ++e) p.AOB[m * VW + h * RDV + e] = f2bf(silu_f(bf2f(g[e])) * ((o[e] - mu) * rstd * p.ret_gn_g[h * RDV + e] + p.ret_gn_b[h * RDV + e]));
}
HD void it_att(const Ptrs& p, long i) {
    using namespace cfg; const int dc = (int)(i % (AD / 8)), head = (int)(i / (AD / 8)) % AH, g = (int)(i / (AD / 8 * AH)) % NG; const int m = (int)(i / (AD / 8 * AH * NG));
    const int dl = dil(g), nb = nback(g), lb = lbuf(g); const float slope = alibi_slope(g, head) * (float)dl, scale = 1.0f / sqrtf((float)AD);
    const bf16* q = p.QKV + (size_t)m * NATT + g * AO + head * AD;
    float mx = -INFINITY, l = 0.f, a0 = 0.f, a1 = 0.f, a2 = 0.f, a3 = 0.f, a4 = 0.f, a5 = 0.f, a6 = 0.f, a7 = 0.f;
    const bool prompt = m < MP; const int t = prompt ? m % SEQ : (m - MP) % DS; const int nsmp = prompt ? 0 : (m - MP) / DS;
    for (int j = 0; j <= nb; ++j) {
        const bf16* kb = nullptr; const float* kf = nullptr;
        if (prompt) { const int pos = t - j * dl; if (pos < 0) break; kb = p.QKV + (size_t)(m - j * dl) * NATT + 3 * AO + g * AO + head * AD; }
        else { const int idx = lb + t - j * dl; if (idx < 0) break;
            if (idx >= lb) kb = p.QKV + ((size_t)MP + (size_t)nsmp * DS + (idx - lb)) * NATT + 3 * AO + g * AO + head * AD;
            else kf = cache_ptr(p, g) + (((size_t)nsmp * lb + idx) * 2) * AO + head * AD; }
        float sc = 0.f, v0, v1, v2, v3, v4, v5, v6, v7;
        if (kb) { for (int d = 0; d < AD; ++d) sc += bf2f(q[d]) * bf2f(kb[d]); const bf16* vb = kb + 3 * AO + dc * 8;
            v0 = bf2f(vb[0]); v1 = bf2f(vb[1]); v2 = bf2f(vb[2]); v3 = bf2f(vb[3]); v4 = bf2f(vb[4]); v5 = bf2f(vb[5]); v6 = bf2f(vb[6]); v7 = bf2f(vb[7]); }
        else { for (int d = 0; d < AD; ++d) sc += bf2f(q[d]) * kf[d]; const float* vf = kf + AO + dc * 8;
            v0 = vf[0]; v1 = vf[1]; v2 = vf[2]; v3 = vf[3]; v4 = vf[4]; v5 = vf[5]; v6 = vf[6]; v7 = vf[7]; }
        sc = sc * scale - slope * (float)j;
        const float mn = sc > mx ? sc : mx, f = expf(mx - mn), pj = expf(sc - mn);
        l = l * f + pj; mx = mn;
        a0 = a0 * f + pj * v0; a1 = a1 * f + pj * v1; a2 = a2 * f + pj * v2; a3 = a3 * f + pj * v3; a4 = a4 * f + pj * v4; a5 = a5 * f + pj * v5; a6 = a6 * f + pj * v6; a7 = a7 * f + pj * v7;
    }
    float* o = p.OG + ((size_t)g * M + m) * AO + head * AD + dc * 8; const float rl = 1.0f / l;
    o[0] = a0 * rl; o[1] = a1 * rl; o[2] = a2 * rl; o[3] = a3 * rl; o[4] = a4 * rl; o[5] = a5 * rl; o[6] = a6 * rl; o[7] = a7 * rl;
    if (dc == 0) p.LSE[((size_t)g * M + m) * AH + head] = mx + logf(l);
}
HD void it_att_merge(const Ptrs& p, long i) {
    using namespace cfg; const size_t m = (size_t)(i / AO); const int c = (int)(i % AO), head = c / AD;
    const float l0 = p.LSE[((size_t)0 * M + m) * AH + head], l1 = p.LSE[((size_t)1 * M + m) * AH + head], l2 = p.LSE[((size_t)2 * M + m) * AH + head];
    const float mx = fmaxf(l0, fmaxf(l1, l2)), w0 = expf(l0 - mx), w1 = expf(l1 - mx), w2 = expf(l2 - mx);
    const float acc = w0 * p.OG[((size_t)0 * M + m) * AO + c] + w1 * p.OG[((size_t)1 * M + m) * AO + c] + w2 * p.OG[((size_t)2 * M + m) * AO + c];
    p.OB[i] = f2bf(acc / (w0 + w1 + w2));
}
HD void it_kv_out(const Ptrs& p, long i) {
    using namespace cfg; long r = i;
    for (int g = 0; g < NG; ++g) {
        const long np = (long)BATCH * keep(g) * 2 * AO, ns = (long)MS * 2 * AO;
        if (r < np) { const int c = (int)(r % AO), kv = (int)(r / AO) % 2, row = (int)(r / (2 * AO)) % keep(g), n = (int)(r / ((long)2 * AO * keep(g)));
            const size_t m = (size_t)n * SEQ + (SEQ - keep(g)) + row; p.out[O_KV0 + i] = bf2f(p.QKV[m * NATT + (1 + kv) * 3 * AO + g * AO + c]); return; }
        r -= np;
        if (r < ns) { const int c = (int)(r % AO), kv = (int)(r / AO) % 2; const size_t m = (size_t)MP + (size_t)(r / (2 * AO)); p.out[O_KV0 + i] = bf2f(p.QKV[m * NATT + (1 + kv) * 3 * AO + g * AO + c]); return; }
        r -= ns;
    }
}
HD long kv_out_total() { using namespace cfg; long t = 0; for (int g = 0; g < NG; ++g) t += (long)BATCH * keep(g) * 2 * AO + (long)MS * 2 * AO; return t; }

#ifndef HOST_SIM
namespace pg8 {
#define PG8_LAS __attribute__((address_space(3)))
typedef unsigned short bf16_t;
typedef short bf16x8 __attribute__((ext_vector_type(8)));
typedef float f32x4 __attribute__((ext_vector_type(4)));
typedef unsigned u32x4 __attribute__((ext_vector_type(4)));
constexpr int BM = 256, BK = 64, HALF = 128, HTB = HALF * BK * 2  , STAGE_BYTES = 8 * HTB, NXCD = 8, WGM = 8;

__host__ __device__ __forceinline__ int lds_byte(int r, int c) { const int st = (r >> 4) * 2 + (c >> 5), rr = r & 15, cc = c & 31, ob = rr * 64 + cc * 2; return st * 1024 + (ob ^ (((ob >> 9) & 1) << 5)); }
__host__ __device__ __forceinline__ void stage_rc(int b, int& R, int& C) { const int st = b / 1024, sb = b % 1024, swz = sb ^ (((sb >> 9) & 1) << 5); R = (st >> 1) * 16 + swz / 64; C = (st & 1) * 32 + (swz % 64) / 2; }
__host__ __device__ __forceinline__ int perm32(int rho) { const int n = rho >> 4, i = rho & 15; return 8 * (i >> 2) + 4 * n + (i & 3); }

struct Unit { int pm, pn; };
struct Gemm { const bf16_t* A; const bf16_t* Bt; int M, N, K; };

struct StaticOrder {
    int nM, nN, nwg, G, c;
    __host__ __device__ void init(int M, int N, int G_, int c_) { nM = M / BM; nN = N / BM; nwg = nM * nN; G = G_; c = c_; }
    __host__ __device__ bool next(int i, Unit& u) const {
        const long L = (long)i * G + c; if (L >= nwg) return false;
        int wgid = (int)L; { const int q = nwg / NXCD, r = nwg % NXCD, xcd = wgid % NXCD, off = wgid / NXCD; wgid = (xcd < r ? xcd * (q + 1) : r * (q + 1) + (xcd - r) * q) + off; }
        const int nig = WGM * nN, gid = wgid / nig, fm = gid * WGM, gsz = (nM - fm) < WGM ? (nM - fm) : WGM;
        u.pm = fm + ((wgid % nig) % gsz); u.pn = (wgid % nig) / gsz; return true;
    }
    __device__ __forceinline__ void a_ready(const Unit&) const {}
    __device__ __forceinline__ void done(const Unit&) const {}
};

__device__ __forceinline__ unsigned cvt_pk_bf16(float lo, float hi) { unsigned r; asm volatile("v_cvt_pk_bf16_f32 %0, %1, %2" : "=v"(r) : "v"(lo), "v"(hi)); return r; }
typedef float f32x2 __attribute__((ext_vector_type(2)));
__device__ __forceinline__ f32x2 gelu_pk(f32x2 v) {
    const f32x2 av = __builtin_elementwise_abs(v), d = av * 0.2316418882f + 1.0f;
    f32x2 t; t.x = __builtin_amdgcn_rcpf(d.x); t.y = __builtin_amdgcn_rcpf(d.y);
    f32x2 q = t * 0.5307027145f + (-0.7265760135f); q = q * t + 0.7107068705f; q = q * t + (-0.142248368f); q = q * t + 0.127414796f; q = q * t;
    const f32x2 s = (v * v) * (-0.72134752044f);
    f32x2 e; e.x = __builtin_amdgcn_exp2f(s.x); e.y = __builtin_amdgcn_exp2f(s.y);
    const f32x2 m = v * (q * e), r = v - m;
    f32x2 o; o.x = v.x < 0.f ? m.x : r.x; o.y = v.y < 0.f ? m.y : r.y; return o;
}

template <int ACT  > struct EpiBf16 {
    static constexpr bool PERM = true, AFTER_DRAIN = false; static_assert(ACT == 0 || ACT == 1, "EpiBf16: ACT is 0 (none) or 1 (gelu_pk)");
    bf16_t* O; int ldc; const float* bias; int split_cols; size_t split_stride; float scale0;
    __device__ __forceinline__ void operator()(const f32x4 (&acc)[2][2][4][2], const Unit& u, int wr, int wc, int fr, int fq) const {
        const int row0 = u.pm * BM + wr * 64 + fr; int colt = u.pn * BM; bf16_t* base = O;
        float sc = 1.f; if (split_cols) { const int t = colt / split_cols; base += (size_t)t * split_stride; colt -= t * split_cols; if (t == 0) sc = scale0; }
        const int col0 = colt + wc * 32 + 8 * fq, bcol0 = u.pn * BM + wc * 32 + 8 * fq;
        f32x4 bv[2][2];
#pragma unroll
        for (int bj = 0; bj < 2; ++bj)
#pragma unroll
            for (int n = 0; n < 2; ++n) bv[bj][n] = bias ? *(const f32x4*)(bias + bcol0 + bj * HALF + 4 * n) : (f32x4){0.f, 0.f, 0.f, 0.f};
#pragma unroll
        for (int ai = 0; ai < 2; ++ai)
#pragma unroll
            for (int m = 0; m < 4; ++m) { bf16_t* rowp = base + (size_t)(row0 + ai * HALF + m * 16) * ldc + col0;
#pragma unroll
                for (int bj = 0; bj < 2; ++bj) { f32x4 v0 = acc[ai][bj][m][0] + bv[bj][0], v1 = acc[ai][bj][m][1] + bv[bj][1];
                    if (ACT == 1) { f32x2 a = gelu_pk((f32x2){v0[0], v0[1]}), b = gelu_pk((f32x2){v0[2], v0[3]}), c = gelu_pk((f32x2){v1[0], v1[1]}), d = gelu_pk((f32x2){v1[2], v1[3]});
                        v0 = (f32x4){a.x, a.y, b.x, b.y}; v1 = (f32x4){c.x, c.y, d.x, d.y}; }
                    v0 = v0 * sc; v1 = v1 * sc; u32x4 w; w.x = cvt_pk_bf16(v0[0], v0[1]); w.y = cvt_pk_bf16(v0[2], v0[3]); w.z = cvt_pk_bf16(v1[0], v1[1]); w.w = cvt_pk_bf16(v1[2], v1[3]);
                    *(u32x4*)(rowp + bj * HALF) = w; } }
    }
};

struct EpiF32 {
    static constexpr bool PERM = false, AFTER_DRAIN = false;
    float* C; int ldc; const float* bias;
    __device__ __forceinline__ void operator()(const f32x4 (&acc)[2][2][4][2], const Unit& u, int wr, int wc, int fr, int fq) const {
        const int row0 = u.pm * BM + wr * 64 + fr, col0 = u.pn * BM + wc * 32 + 4 * fq;
        f32x4 bv[2][2];
#pragma unroll
        for (int bj = 0; bj < 2; ++bj)
#pragma unroll
            for (int n = 0; n < 2; ++n) bv[bj][n] = bias ? *(const f32x4*)(bias + col0 + bj * HALF + n * 16) : (f32x4){0.f, 0.f, 0.f, 0.f};
#pragma unroll
        for (int ai = 0; ai < 2; ++ai)
#pragma unroll
            for (int m = 0; m < 4; ++m) { float* rowp = C + (size_t)(row0 + ai * HALF + m * 16) * ldc + col0;
#pragma unroll
                for (int bj = 0; bj < 2; ++bj)
#pragma unroll
                    for (int n = 0; n < 2; ++n) *(f32x4*)(rowp + bj * HALF + n * 16) = acc[ai][bj][m][n] + bv[bj][n]; }
    }
};
struct EpiSwiglu {
    static constexpr bool PERM = true, AFTER_DRAIN = false;
    bf16_t* O; int ldc;
    __device__ __forceinline__ void operator()(const f32x4 (&acc)[2][2][4][2], const Unit& u, int wr, int wc, int fr, int fq) const {
        const int row0 = u.pm * BM + wr * 64 + fr, col0 = u.pn * HALF + wc * 32 + 8 * fq;
#pragma unroll
        for (int ai = 0; ai < 2; ++ai)
#pragma unroll
            for (int m = 0; m < 4; ++m) { bf16_t* rowp = O + (size_t)(row0 + ai * HALF + m * 16) * ldc + col0;
                const f32x4 a0 = acc[ai][0][m][0], a1 = acc[ai][0][m][1], b0 = acc[ai][1][m][0], b1 = acc[ai][1][m][1];
                u32x4 w; w.x = cvt_pk_bf16(swiglu_f(a0[0], b0[0]), swiglu_f(a0[1], b0[1])); w.y = cvt_pk_bf16(swiglu_f(a0[2], b0[2]), swiglu_f(a0[3], b0[3]));
                w.z = cvt_pk_bf16(swiglu_f(a1[0], b1[0]), swiglu_f(a1[1], b1[1])); w.w = cvt_pk_bf16(swiglu_f(a1[2], b1[2]), swiglu_f(a1[3], b1[3]));
                *(u32x4*)rowp = w; }
    }
};
template <class Epi, class Sched, bool ALIGN_EPI = false, bool SP2 = false>
__device__ __forceinline__ void gemm_phase(PG8_LAS unsigned char* lds, const Gemm g, const Sched& S, const Epi& E) {
    const int tid = threadIdx.x, wid = __builtin_amdgcn_readfirstlane(tid >> 6), lane = tid & 63, wr = wid >> 2, wc = wid & 3, fr = lane & 15, fq = lane >> 4;
    const int K = g.K, nt = K / BK;
    unsigned voffA[2], voffB[2];
#pragma unroll
    for (int i = 0; i < 2; ++i) { int R, C; stage_rc(tid * 16 + i * 8192, R, C); const int Rb = Epi::PERM ? ((R & ~31) + perm32(R & 31)) : R;
        voffA[i] = (unsigned)(R * K + C) * 2u; voffB[i] = (unsigned)(Rb * K + C) * 2u; }
    const size_t kstep = (size_t)(BK * 2);
    const size_t hstep = (size_t)HALF * K * 2;
    const size_t tstep = 2 * hstep;
    const unsigned ldsw = (unsigned)wid * 1024u;
    const int aoff = lds_byte(wr * 64 + fr, fq * 8), boff = lds_byte(wc * 32 + fr, fq * 8);
#define PG8_SA(b, h) (((b) * 2 + (h)) * HTB)
#define PG8_SB(b, h) ((4 + (b) * 2 + (h)) * HTB)
#define PG8_STAGE(bufoff, gbase, voff) do { _Pragma("unroll") for (int _i = 0; _i < 2; ++_i) \
        __builtin_amdgcn_global_load_lds((const unsigned*)((const char*)(gbase) + (voff)[_i]), (PG8_LAS unsigned*)(lds + (bufoff) + ldsw + _i * 8192), 16, 0, 0); } while (0)
#define PG8_LDA(dst, b, h) do { _Pragma("unroll") for (int m = 0; m < 4; ++m) _Pragma("unroll") for (int k = 0; k < 2; ++k) dst[m][k] = *(const PG8_LAS bf16x8*)(lds + PG8_SA(b, h) + aoff + m * 2048 + k * 1024); } while (0)
#define PG8_LDB(dst, b, h) do { _Pragma("unroll") for (int n = 0; n < 2; ++n) _Pragma("unroll") for (int k = 0; k < 2; ++k) dst[n][k] = *(const PG8_LAS bf16x8*)(lds + PG8_SB(b, h) + boff + n * 2048 + k * 1024); } while (0)
#define PG8_MMA(ai, bj, At, Bt) do { __builtin_amdgcn_s_setprio(1); _Pragma("unroll") for (int m = 0; m < 4; ++m) _Pragma("unroll") for (int n = 0; n < 2; ++n) _Pragma("unroll") for (int k = 0; k < 2; ++k) \
        acc[ai][bj][m][n] = __builtin_amdgcn_mfma_f32_16x16x32_bf16(Bt[n][k], At[m][k], acc[ai][bj][m][n], 0, 0, 0); __builtin_amdgcn_s_setprio(0); } while (0)
#define PG8_WAIT_V(n) asm volatile("s_waitcnt vmcnt(" #n ")" ::: "memory")
#define PG8_WAIT_L(n) asm volatile("s_waitcnt lgkmcnt(" #n ")" ::: "memory")
#define PG8_BAR __builtin_amdgcn_s_barrier()
#define PG8_SCHED __builtin_amdgcn_sched_barrier(0)
    Unit cur, nxt; int ui = 0;
    if (!S.next(0, cur)) return;
    f32x4 acc[2][2][4][2];
#pragma unroll
    for (int a = 0; a < 2; ++a)
#pragma unroll
        for (int b = 0; b < 2; ++b)
#pragma unroll
            for (int m = 0; m < 4; ++m)
#pragma unroll
                for (int n = 0; n < 2; ++n) acc[a][b][m][n] = (f32x4){0.f, 0.f, 0.f, 0.f};
    bf16x8 At[4][2], B0[2][2], B1[2][2];
    const char* cA = (const char*)g.A + (size_t)cur.pm * tstep; const char* cB = (const char*)g.Bt + (size_t)cur.pn * tstep;
    S.a_ready(cur);
    if constexpr (SP2) {
        PG8_STAGE(PG8_SB(0, 0), cB, voffB); PG8_STAGE(PG8_SB(0, 1), cB + hstep, voffB); PG8_STAGE(PG8_SA(0, 0), cA, voffA); PG8_STAGE(PG8_SA(0, 1), cA + hstep, voffA);
        if (wr == 1) PG8_BAR;
        PG8_WAIT_V(2); PG8_BAR;
        PG8_STAGE(PG8_SB(1, 0), cB + kstep, voffB); PG8_STAGE(PG8_SA(1, 0), cA + kstep, voffA); PG8_STAGE(PG8_SB(1, 1), cB + hstep + kstep, voffB);
        PG8_WAIT_V(6); PG8_BAR;
    } else {
        PG8_STAGE(PG8_SB(0, 0), cB, voffB); PG8_STAGE(PG8_SA(0, 0), cA, voffA); PG8_STAGE(PG8_SB(0, 1), cB + hstep, voffB); PG8_STAGE(PG8_SA(0, 1), cA + hstep, voffA);
        if (wr == 1) PG8_BAR;
        PG8_WAIT_V(4); PG8_BAR;
        PG8_STAGE(PG8_SB(1, 0), cB + kstep, voffB); PG8_STAGE(PG8_SA(1, 0), cA + kstep, voffA); PG8_STAGE(PG8_SB(1, 1), cB + hstep + kstep, voffB);
        PG8_WAIT_V(6); PG8_BAR;
    }
    for (;;) {
        const bool has_next = S.next(ui + 1, nxt);
        const char* nA = has_next ? (const char*)g.A + (size_t)nxt.pm * tstep : cA; const char* nB = has_next ? (const char*)g.Bt + (size_t)nxt.pn * tstep : cB;
        for (int t = 0; t < nt; t += 2) {
            const bool last = (t == nt - 2);
            const char* a1 = cA + (size_t)(t + 1) * kstep;
            const char* a2 = last ? nA : cA + (size_t)(t + 2) * kstep; const char* b2 = last ? nB : cB + (size_t)(t + 2) * kstep;
            const char* a3 = a2 + kstep; const char* b3 = b2 + kstep;
            if (last && has_next) S.a_ready(nxt);
            if constexpr (SP2) {
            PG8_LDB(B0, 0, 0); PG8_LDB(B1, 0, 1); PG8_SCHED; PG8_LDA(At, 0, 0); PG8_STAGE(PG8_SA(1, 1), a1 + hstep, voffA);
            PG8_WAIT_V(8); PG8_WAIT_L(0); PG8_BAR; PG8_MMA(0, 0, At, B0); PG8_MMA(0, 1, At, B1); PG8_BAR; PG8_SCHED;
            PG8_LDA(At, 0, 1); PG8_STAGE(PG8_SB(0, 0), b2, voffB); PG8_STAGE(PG8_SB(0, 1), b2 + hstep, voffB); PG8_STAGE(PG8_SA(0, 0), a2, voffA);
            PG8_WAIT_V(8); PG8_WAIT_L(0); PG8_BAR; PG8_MMA(1, 0, At, B0); PG8_MMA(1, 1, At, B1); PG8_BAR; PG8_SCHED;
            PG8_LDB(B0, 1, 0); PG8_LDB(B1, 1, 1); PG8_SCHED; PG8_LDA(At, 1, 0); PG8_STAGE(PG8_SA(0, 1), a2 + hstep, voffA);
            PG8_WAIT_V(8); PG8_WAIT_L(0); PG8_BAR; PG8_MMA(0, 0, At, B0); PG8_MMA(0, 1, At, B1); PG8_BAR; PG8_SCHED;
            PG8_LDA(At, 1, 1); PG8_STAGE(PG8_SB(1, 0), b3, voffB); PG8_STAGE(PG8_SB(1, 1), b3 + hstep, voffB); PG8_STAGE(PG8_SA(1, 0), a3, voffA);
            PG8_WAIT_V(8); PG8_WAIT_L(0); PG8_BAR; PG8_MMA(1, 0, At, B0); PG8_MMA(1, 1, At, B1); PG8_BAR; PG8_SCHED;
            } else {
            PG8_LDB(B0, 0, 0); PG8_SCHED; PG8_LDA(At, 0, 0); PG8_STAGE(PG8_SA(1, 1), a1 + hstep, voffA);
            PG8_WAIT_L(8); PG8_BAR; PG8_WAIT_L(0); PG8_MMA(0, 0, At, B0); PG8_BAR; PG8_SCHED;
            PG8_LDB(B1, 0, 1); PG8_STAGE(PG8_SB(0, 0), b2, voffB);
            PG8_BAR; PG8_WAIT_L(0); PG8_MMA(0, 1, At, B1); PG8_BAR;
            PG8_LDA(At, 0, 1); PG8_STAGE(PG8_SA(0, 0), a2, voffA);
            PG8_BAR; PG8_WAIT_L(0); PG8_MMA(1, 0, At, B0); PG8_BAR; PG8_SCHED;
            PG8_STAGE(PG8_SB(0, 1), b2 + hstep, voffB);
            PG8_WAIT_V(6); PG8_BAR; PG8_MMA(1, 1, At, B1); PG8_BAR;
            PG8_LDB(B0, 1, 0); PG8_SCHED; PG8_LDA(At, 1, 0); PG8_STAGE(PG8_SA(0, 1), a2 + hstep, voffA);
            PG8_WAIT_L(8); PG8_BAR; PG8_WAIT_L(0); PG8_MMA(0, 0, At, B0); PG8_BAR; PG8_SCHED;
            PG8_LDB(B1, 1, 1); PG8_STAGE(PG8_SB(1, 0), b3, voffB);
            PG8_BAR; PG8_WAIT_L(0); PG8_MMA(0, 1, At, B1); PG8_BAR;
            PG8_LDA(At, 1, 1); PG8_STAGE(PG8_SA(1, 0), a3, voffA);
            PG8_BAR; PG8_WAIT_L(0); PG8_MMA(1, 0, At, B0); PG8_BAR; PG8_SCHED;
            PG8_STAGE(PG8_SB(1, 1), b3 + hstep, voffB);
            PG8_WAIT_V(6); PG8_BAR; PG8_MMA(1, 1, At, B1); PG8_BAR;
            }
        }
        if constexpr (ALIGN_EPI) { if (wr == 0) PG8_BAR; }
        if constexpr (!Epi::AFTER_DRAIN) { E(acc, cur, wr, wc, fr, fq); S.done(cur); }
        if (!has_next) break;
#pragma unroll
        for (int a = 0; a < 2; ++a)
#pragma unroll
            for (int b = 0; b < 2; ++b)
#pragma unroll
                for (int m = 0; m < 4; ++m)
#pragma unroll
                    for (int n = 0; n < 2; ++n) acc[a][b][m][n] = (f32x4){0.f, 0.f, 0.f, 0.f};
        cur = nxt; cA = nA; cB = nB; ++ui;
        if constexpr (ALIGN_EPI) { if (wr == 1) PG8_BAR; }
    }
    PG8_WAIT_V(0);
    if constexpr (!ALIGN_EPI) { if (wr == 0) PG8_BAR; }
    PG8_BAR;
    if constexpr (Epi::AFTER_DRAIN) { E.fused(acc, cur, wr, wc, fr, fq, lds, wid, lane); S.done(cur); }
#undef PG8_SA
#undef PG8_SB
#undef PG8_STAGE
#undef PG8_LDA
#undef PG8_LDB
#undef PG8_MMA
#undef PG8_WAIT_V
#undef PG8_WAIT_L
#undef PG8_BAR
#undef PG8_SCHED
}
}

#define GAS __attribute__((address_space(1)))
#define LAS __attribute__((address_space(3)))
typedef unsigned v4u __attribute__((ext_vector_type(4)));
typedef float f32x4 __attribute__((ext_vector_type(4)));
typedef short bf16x8 __attribute__((ext_vector_type(8)));
typedef GAS unsigned gu32;
typedef GAS unsigned long long gu64;
#define RLX_AGENT __ATOMIC_RELAXED, __HIP_MEMORY_SCOPE_AGENT
#define LDS_WAIT() asm volatile("s_waitcnt lgkmcnt(0)" ::: "memory")
#define VM_WAIT() asm volatile("s_waitcnt vmcnt(0)" ::: "memory")
__device__ __forceinline__ unsigned long long rt() { return __builtin_amdgcn_s_memrealtime(); }
__device__ __forceinline__ unsigned pk2(float lo, float hi) { return f2bf_u(lo) | (f2bf_u(hi) << 16); }

#define XB_TMO      128
#define XB_XCNT(j)  (256  + 64 * (j))
#define XB_XSUB(j)  (1280 + 64 * (j))
#define XB_XGEN(j)  (2304 + 64 * (j))
#define XB_TOP      3328
#define XB_TOPGEN   3392
#define XCD_BAR_WORDS 3456
#define XB_SPIN_CAP (1u << 18)

__device__ __forceinline__ unsigned xb_ld(unsigned* p)              { return __hip_atomic_load(p, __ATOMIC_RELAXED, __HIP_MEMORY_SCOPE_AGENT); }
__device__ __forceinline__ unsigned xb_add(unsigned* p, unsigned v) { return __hip_atomic_fetch_add(p, v, __ATOMIC_RELAXED, __HIP_MEMORY_SCOPE_AGENT); }
__device__ __forceinline__ unsigned xb_xcc_id() { return (unsigned)__builtin_amdgcn_s_getreg((3 << 11) | 20) & 0xFu; }
#define XB_SPIN(cond, bar) do { unsigned _sp = 0; while (cond) { __builtin_amdgcn_s_sleep(1); \
    if ((++_sp & 255u) == 0u) { if (xb_ld(&(bar)[XB_TMO])) break; if (_sp > XB_SPIN_CAP) { atomicAdd(&(bar)[XB_TMO], 1u); break; } } } } while (0)

struct XcdBarrier {
    unsigned* bar; unsigned x;
    volatile LAS unsigned* st;
};

__device__ __forceinline__ XcdBarrier xcd_barrier_post(unsigned* bar, volatile LAS unsigned* st) {
    XcdBarrier b; b.bar = bar; b.x = xb_xcc_id(); b.st = st;
    if (threadIdx.x == 0) (void)xb_add(&bar[XB_XCNT(b.x)], 1u);
    return b;
}
__device__ __forceinline__ void xcd_barrier_complete(unsigned* bar, unsigned x, unsigned& nloc, unsigned& nx) {
    const unsigned G = gridDim.x * gridDim.y * gridDim.z;
    unsigned sum, cnt, mine, sp = 0u;
    for (;;) {
        sum = 0u; cnt = 0u; mine = 0u;
#pragma unroll
        for (unsigned j = 0; j < 16; ++j) { const unsigned c = xb_ld(&bar[XB_XCNT(j)]); sum += c; cnt += (c > 0u) ? 1u : 0u; mine = (j == x) ? c : mine; }
        if (sum == G) break;
        __builtin_amdgcn_s_sleep(1);
        if ((++sp & 255u) == 0u) { if (xb_ld(&bar[XB_TMO])) break; if (sp > XB_SPIN_CAP) { atomicAdd(&bar[XB_TMO], 1u); break; } }
    }
    nloc = mine > 0u ? mine : 1u; nx = cnt > 0u ? cnt : 1u;
}

__device__ __forceinline__ void xcd_barrier(const XcdBarrier& b) {
    asm volatile("s_waitcnt vmcnt(0)" ::: "memory");
    __syncthreads();
    if (threadIdx.x == 0) {
        unsigned* bar = b.bar;
        __builtin_amdgcn_s_waitcnt(0);
        unsigned nloc = b.st[0], nx = b.st[1];
        if (nloc == 0u) { xcd_barrier_complete(bar, b.x, nloc, nx); b.st[0] = nloc; b.st[1] = nx; }
        const unsigned old = xb_add(&bar[XB_XSUB(b.x)], 1u);
        const unsigned gen = old / nloc;
        if (old + 1u == (gen + 1u) * nloc) {
            __builtin_amdgcn_fence(__ATOMIC_RELEASE, "agent");
            asm volatile("s_waitcnt vmcnt(0)" ::: "memory");
            const unsigned og = xb_add(&bar[XB_TOP], 1u);
            const unsigned tg = og / nx;
            if (og + 1u == (tg + 1u) * nx) xb_add(&bar[XB_TOPGEN], 1u);
            else XB_SPIN(xb_ld(&bar[XB_TOPGEN]) == tg, bar);
            __builtin_amdgcn_fence(__ATOMIC_ACQUIRE, "agent");
            xb_add(&bar[XB_XGEN(b.x)], 1u);
            asm volatile("s_waitcnt vmcnt(0)" ::: "memory");
        } else {
            XB_SPIN(xb_ld(&bar[XB_XGEN(b.x)]) == gen, bar);
            __builtin_amdgcn_fence(__ATOMIC_ACQUIRE, "agent");
            asm volatile("s_waitcnt vmcnt(0)" ::: "memory");
        }
    }
    __syncthreads();
}

constexpr int NWAVES = 8, NT = NWAVES * 64;
#ifndef MK_ONE_LAUNCH
#define MK_ONE_LAUNCH 0
#endif
constexpr int PH_PRO = 0, PH_ADA = 1, PH_MOD0 = 2, PH_L0 = 3, PH_PER_LAYER = 13, NPH = PH_L0 + 2 * PH_PER_LAYER;
enum Slot { S_G1A = 0, S_G2A, S_LNA, S_MIN, S_MA, S_MB, S_MC, S_MD, S_MOUT, S_LNM, S_G1B, S_G2B, S_LNB };
namespace wsm {
using namespace cfg;
constexpr size_t al(size_t x) { return (x + 4095) & ~(size_t)4095; }
constexpr size_t CTL = 0, CTL_BYTES = 1u << 20;
constexpr size_t WFI = al(CTL + CTL_BYTES);
constexpr size_t WFO = al(WFI + (size_t)4 * NFF * D * 2);
constexpr size_t WRI = al(WFO + (size_t)4 * D * FF * 2);
constexpr size_t WRO = al(WRI + (size_t)NRET * D * 2);
constexpr size_t WAI = al(WRO + (size_t)D * VW * 2);
constexpr size_t WAO = al(WAI + (size_t)NATT * D * 2);
constexpr size_t WADA = al(WAO + (size_t)D * AO * 2);
constexpr size_t SC = al(WADA + (size_t)18 * D * D * 2);
constexpr size_t ADA = al(SC + (size_t)SCR * D * 2);
constexpr size_t X = al(ADA + (size_t)SCR * ADA_LD * 4);
constexpr size_t Y = al(X + (size_t)M * D * 4);
constexpr size_t XN = al(Y + (size_t)M * D * 4);
constexpr size_t H = al(XN + (size_t)M * D * 2);
constexpr size_t QKV = al(H + (size_t)M * FF * 2);
constexpr size_t AOB = al(QKV + (size_t)M * NRET * 2);
constexpr size_t OB = al(AOB + (size_t)M * VW * 2);
constexpr size_t U = al(OB + (size_t)M * AO * 2);
constexpr size_t SIN = al(U + (size_t)NITEM * RDK * RDV * 4);
constexpr size_t PS = al(SIN + (size_t)NITEM * RDK * RDV * 4);
constexpr size_t ORET = al(PS + (size_t)NITEM * RC * RC * 4);
constexpr size_t OG = al(ORET + (size_t)M * VW * 4);
constexpr size_t LSE = al(OG + (size_t)3 * M * AO * 4);
constexpr size_t END = al(LSE + (size_t)3 * M * AH * 4);
static_assert(NRET >= NATT, "QKV buffer is sized by the retention projection");
}
constexpr int CW_TMO = 0, CW_CODE = 1, CW_BAR = 4096;
constexpr int RING_OFF = 0, RING_BYTES = 131072;
constexpr int LDSCTL_OFF = RING_BYTES, MISC_OFF = LDSCTL_OFF + 320;
constexpr int LDS_BYTES = 147456;

struct Args { Ptrs p; int ph_lo, ph_hi; };

__device__ __forceinline__ const Args* kargs() { auto k = __builtin_amdgcn_kernarg_segment_ptr(); asm volatile("" : "+s"(k)); return (const Args*)k; }
#define GRID_ITEMS(total, call) do { const long _tot = (long)(total); for (long _i = (long)blockIdx.x * NT + threadIdx.x; _i < _tot; _i += (long)gridDim.x * NT) { call; } } while (0)

__device__ __forceinline__ void p0_transpose_item(const float* W, int K, int N, bf16* WT, int ffn, int row_off, LAS float* scr, int item, int lane) {
    const int nblk = N / 32, kb = item / nblk, nb = item % nblk, k0 = 64 * kb, n0 = 32 * nb;
    const int dst0 = ffn ? ffn_dst_of_src(n0) : row_off + n0;
#pragma unroll 8
    for (int i = 0; i < 32; ++i) { const int kk = 2 * i + (lane >> 5); scr[kk * 33 + (lane & 31)] = W[(size_t)(k0 + kk) * N + n0 + (lane & 31)]; }
    LDS_WAIT(); asm volatile("" ::: "memory");
    const int c = lane & 7;
#pragma unroll
    for (int j = 0; j < 4; ++j) { const int n = (lane >> 3) + 8 * j; const LAS float* s = scr + (8 * c) * 33 + n;
        v4u o; o.x = pk2(s[0 * 33], s[1 * 33]); o.y = pk2(s[2 * 33], s[3 * 33]); o.z = pk2(s[4 * 33], s[5 * 33]); o.w = pk2(s[6 * 33], s[7 * 33]);
        *(GAS v4u*)(WT + (size_t)(dst0 + n) * K + k0 + 8 * c) = o; }
    LDS_WAIT(); asm volatile("" ::: "memory");
}
__device__ __forceinline__ void p0_prologue(const Ptrs& p, LAS unsigned char* lds, int wave, int lane) {
    using namespace cfg;
    LAS float* scr = (LAS float*)(lds + RING_OFF + wave * 16384);
    const int gw = blockIdx.x * NWAVES + wave, NGW = gridDim.x * NWAVES;
    constexpr int I_FI = (D / 64) * (NFF / 32), I_FO = (FF / 64) * (D / 32), I_RI = (D / 64) * (NRET / 32), I_RO = (VW / 64) * (D / 32), I_AI = (D / 64) * (NATT / 32), I_AO = (AO / 64) * (D / 32), I_AD = (D / 64) * (9 * D / 32);
    constexpr int NITEMS = 4 * I_FI + 4 * I_FO + I_RI + I_RO + I_AI + I_AO + 2 * I_AD;
    for (int it = gw; it < NITEMS; it += NGW) {
        int r = it;
        if (r < 4 * I_FI) { const int w = r / I_FI; p0_transpose_item(p.w_ffn_in + (size_t)w * D * NFF, D, NFF, p.wfi_t + (size_t)w * NFF * D, 1, 0, scr, r % I_FI, lane); continue; } r -= 4 * I_FI;
        if (r < 4 * I_FO) { const int w = r / I_FO; p0_transpose_item(p.w_ffn_out + (size_t)w * FF * D, FF, D, p.wfo_t + (size_t)w * D * FF, 0, 0, scr, r % I_FO, lane); continue; } r -= 4 * I_FO;
        if (r < I_RI) { p0_transpose_item(p.w_ret_in, D, NRET, p.wri_t, 0, 0, scr, r, lane); continue; } r -= I_RI;
        if (r < I_RO) { p0_transpose_item(p.w_ret_out, VW, D, p.wro_t, 0, 0, scr, r, lane); continue; } r -= I_RO;
        if (r < I_AI) { p0_transpose_item(p.w_att_in, D, NATT, p.wai_t, 0, 0, scr, r, lane); continue; } r -= I_AI;
        if (r < I_AO) { p0_transpose_item(p.w_att_out, AO, D, p.wao_t, 0, 0, scr, r, lane); continue; } r -= I_AO;
        { const int w = r / I_AD; p0_transpose_item(p.w_ada + (size_t)w * D * 9 * D, D, 9 * D, p.wada_t, 0, w * 9 * D, scr, r % I_AD, lane); }
    }
    GRID_ITEMS((long)SCR * D, it_silu_c(p, _i));
}

#define IN(k) (lo <= (k) && (k) < hi)
#define SEAM(k) do { if (MK_ONE_LAUNCH && IN((k) + 1)) xcd_barrier(bar); } while (0)
template <int L> __device__ __forceinline__ void layer_phases(LAS unsigned char* lds, const XcdBarrier& bar, const int lo, const int hi, const int G) {
    using namespace cfg;
    constexpr int base = PH_L0 + PH_PER_LAYER * L;

        if (IN(base + S_G1A)) { const Ptrs p = kargs()->p;
            pg8::Gemm g{p.XN, p.wfi_t + (size_t)(L * 2 + 0) * NFF * D, M, NFF, D}; pg8::StaticOrder S; S.init(M, NFF, G, (int)blockIdx.x);
            pg8::EpiSwiglu E{p.H, FF};
            pg8::gemm_phase<pg8::EpiSwiglu, pg8::StaticOrder, true, true>(lds + RING_OFF, g, S, E);
            SEAM(base + S_G1A);
        }
        if (IN(base + S_G2A)) { const Ptrs p = kargs()->p;
            pg8::Gemm g{p.H, p.wfo_t + (size_t)(L * 2 + 0) * D * FF, M, D, FF}; pg8::StaticOrder S; S.init(M, D, G, (int)blockIdx.x);
            pg8::EpiF32 E{p.Y, D, nullptr};
            pg8::gemm_phase<pg8::EpiF32, pg8::StaticOrder, true, true>(lds + RING_OFF, g, S, E);
            SEAM(base + S_G2A);
        }
        if (IN(base + S_LNA)) { const Ptrs p = kargs()->p; GRID_ITEMS(M, it_ln_row(p, (int)_i, L, 0, 0.5f, L, 1)); SEAM(base + S_LNA); }
        if constexpr (L == 0) {
            if (IN(base + S_MIN)) { const Ptrs p = kargs()->p;
                pg8::Gemm g{p.XN, p.wri_t, M, NRET, D}; pg8::StaticOrder S; S.init(M, NRET, G, (int)blockIdx.x);
                pg8::EpiBf16<0> E{p.QKV, NRET, nullptr, 0, 0, 1.f};
                pg8::gemm_phase<pg8::EpiBf16<0>, pg8::StaticOrder, true, true>(lds + RING_OFF, g, S, E);
                SEAM(base + S_MIN);
            }
            if (IN(base + S_MA)) { const Ptrs p = kargs()->p;
                GRID_ITEMS((long)NITEM * RDK * RDV, it_ret_local(p, _i));
                GRID_ITEMS((long)NITEM * RC * RC, it_ret_scores(p, _i));
                GRID_ITEMS((long)DB * RH * RDK * RDV, it_rets_state(p, _i));
                GRID_ITEMS((long)MS * RH * RDV, it_rets_out(p, _i));
                SEAM(base + S_MA);
            }
            if (IN(base + S_MB)) { const Ptrs p = kargs()->p; GRID_ITEMS((long)BATCH * RH * RDK * RDV, it_ret_scan(p, _i)); SEAM(base + S_MB); }
            if (IN(base + S_MC)) { const Ptrs p = kargs()->p; GRID_ITEMS((long)NITEM * RC * RDV, it_ret_out(p, _i)); SEAM(base + S_MC); }
            if (IN(base + S_MD)) { const Ptrs p = kargs()->p; GRID_ITEMS((long)M * RH, it_ret_gate(p, _i)); SEAM(base + S_MD); }
            if (IN(base + S_MOUT)) { const Ptrs p = kargs()->p;
                pg8::Gemm g{p.AOB, p.wro_t, M, D, VW}; pg8::StaticOrder S; S.init(M, D, G, (int)blockIdx.x);
                pg8::EpiF32 E{p.Y, D, nullptr};
                pg8::gemm_phase<pg8::EpiF32, pg8::StaticOrder, true, true>(lds + RING_OFF, g, S, E);
                SEAM(base + S_MOUT);
            }
        } else {
            if (IN(base + S_MIN)) { const Ptrs p = kargs()->p;
                pg8::Gemm g{p.XN, p.wai_t, M, NATT, D}; pg8::StaticOrder S; S.init(M, NATT, G, (int)blockIdx.x);
                pg8::EpiBf16<0> E{p.QKV, NATT, nullptr, 0, 0, 1.f};
                pg8::gemm_phase<pg8::EpiBf16<0>, pg8::StaticOrder, true, true>(lds + RING_OFF, g, S, E);
                SEAM(base + S_MIN);
            }
            if (IN(base + S_MA)) { const Ptrs p = kargs()->p;
                GRID_ITEMS((long)M * NG * AH * (AD / 8), it_att(p, _i));
                GRID_ITEMS(kv_out_total(), it_kv_out(p, _i));
                SEAM(base + S_MA);
            }
            if (IN(base + S_MB)) { const Ptrs p = kargs()->p; GRID_ITEMS((long)M * AO, it_att_merge(p, _i)); SEAM(base + S_MB + 2); }
            if (IN(base + S_MOUT)) { const Ptrs p = kargs()->p;
                pg8::Gemm g{p.OB, p.wao_t, M, D, AO}; pg8::StaticOrder S; S.init(M, D, G, (int)blockIdx.x);
                pg8::EpiF32 E{p.Y, D, nullptr};
                pg8::gemm_phase<pg8::EpiF32, pg8::StaticOrder, true, true>(lds + RING_OFF, g, S, E);
                SEAM(base + S_MOUT);
            }
        }
        if (IN(base + S_LNM)) { const Ptrs p = kargs()->p; GRID_ITEMS(M, it_ln_row(p, (int)_i, L, 1, 1.0f, L, 2)); SEAM(base + S_LNM); }
        if (IN(base + S_G1B)) { const Ptrs p = kargs()->p;
            pg8::Gemm g{p.XN, p.wfi_t + (size_t)(L * 2 + 1) * NFF * D, M, NFF, D}; pg8::StaticOrder S; S.init(M, NFF, G, (int)blockIdx.x);
            pg8::EpiSwiglu E{p.H, FF};
            pg8::gemm_phase<pg8::EpiSwiglu, pg8::StaticOrder, true, true>(lds + RING_OFF, g, S, E);
            SEAM(base + S_G1B);
        }
        if (IN(base + S_G2B)) { const Ptrs p = kargs()->p;
            pg8::Gemm g{p.H, p.wfo_t + (size_t)(L * 2 + 1) * D * FF, M, D, FF}; pg8::StaticOrder S; S.init(M, D, G, (int)blockIdx.x);
            pg8::EpiF32 E{p.Y, D, nullptr};
            pg8::gemm_phase<pg8::EpiF32, pg8::StaticOrder, true, true>(lds + RING_OFF, g, S, E);
            SEAM(base + S_G2B);
        }
        if (IN(base + S_LNB)) { const Ptrs p = kargs()->p; GRID_ITEMS(M, it_ln_row(p, (int)_i, L, 2, 0.5f, L + 1, L == 0 ? 0 : -1)); SEAM(base + S_LNB); }
    }
#undef IN
#undef SEAM
__global__ void __launch_bounds__(NT, 2) fwd(Args args) {
    using namespace cfg;
    extern __shared__ __attribute__((aligned(16))) unsigned char lds_raw[];
    LAS unsigned char* lds = (LAS unsigned char*)lds_raw;
    volatile LAS unsigned* MISC = (volatile LAS unsigned*)(lds + MISC_OFF);
    const int tid = threadIdx.x, lane = tid & 63, wave = __builtin_amdgcn_readfirstlane(tid >> 6);
    const int G = gridDim.x;
    for (int u = tid; u < (LDS_BYTES - LDSCTL_OFF) / 4; u += NT) ((LAS unsigned*)(lds + LDSCTL_OFF))[u] = 0u;
    __syncthreads();
    XcdBarrier bar; { unsigned* const ctl = kargs()->p.ctl; bar.bar = ctl + CW_BAR; bar.x = 0; bar.st = nullptr;
    if (MK_ONE_LAUNCH) bar = xcd_barrier_post(ctl + CW_BAR, MISC + 8); }
    const int lo = args.ph_lo, hi = args.ph_hi;
#define IN(k) (lo <= (k) && (k) < hi)
#define SEAM(k) do { if (MK_ONE_LAUNCH && IN((k) + 1)) xcd_barrier(bar); } while (0)

    if (IN(PH_PRO)) { const Ptrs p = kargs()->p; p0_prologue(p, lds, wave, lane); SEAM(PH_PRO); }
    if (IN(PH_ADA)) { const Ptrs p = kargs()->p;
        pg8::Gemm g{p.sc, p.wada_t, SCR, 18 * D, D}; pg8::StaticOrder S; S.init(SCR, 18 * D, G, (int)blockIdx.x);
        pg8::EpiF32 E{p.ada, ADA_LD, p.b_ada};
        pg8::gemm_phase<pg8::EpiF32, pg8::StaticOrder, true, true>(lds + RING_OFF, g, S, E);
        SEAM(PH_ADA);
    }
    if (IN(PH_MOD0)) { const Ptrs p = kargs()->p; GRID_ITEMS((long)M * D, it_mod0(p, _i)); SEAM(PH_MOD0); }

    layer_phases<0>(lds, bar, lo, hi, G);
    layer_phases<1>(lds, bar, lo, hi, G);
#undef IN
#undef SEAM
}

extern "C" void kernel_launch(void* const* d_in, const int* in_sizes, int n_in, void* d_out, int out_size, void* d_ws, size_t ws_size, hipStream_t stream) {
    using namespace cfg;
    static int grid = 0;
    if (grid == 0) {
        const long want_out = O_KV0 + kv_out_total();
        if (n_in != 20 || (long)out_size != want_out || ws_size < wsm::END) { fprintf(stderr, "kernel_launch: shape mismatch: n_in %d out %d (want %ld) ws %zu (want %zu); nothing launched\n", n_in, out_size, want_out, ws_size, (size_t)wsm::END); grid = -1; return; }
        int dev = 0, cus = 0, per_cu = 0;
        if (hipGetDevice(&dev) != hipSuccess || hipDeviceGetAttribute(&cus, hipDeviceAttributeMultiprocessorCount, dev) != hipSuccess) { grid = -1; return; }
        if (hipFuncSetAttribute((const void*)fwd, hipFuncAttributeMaxDynamicSharedMemorySize, LDS_BYTES) != hipSuccess) { fprintf(stderr, "kernel_launch: hipFuncSetAttribute failed\n"); grid = -1; return; }
        if (hipOccupancyMaxActiveBlocksPerMultiprocessor(&per_cu, (const void*)fwd, NT, LDS_BYTES) != hipSuccess || per_cu < 1) fprintf(stderr, "kernel_launch: note: occupancy query reports %d workgroups per CU\n", per_cu);
        (void)hipGetLastError();
        grid = cus;
    }
    if (grid < 0) return;
    unsigned char* ws = (unsigned char*)d_ws;
    if (hipMemsetAsync(ws + wsm::CTL, 0, wsm::CTL_BYTES, stream) != hipSuccess) return;
    Args a{};
    Ptrs& p = a.p; const float* const* in = (const float* const*)d_in;
    p.x_prompt = in[0]; p.x_sample = in[1]; p.c_prompt = in[2]; p.c_sample = in[3]; p.state_ret = in[4]; p.cache0 = in[5]; p.cache1 = in[6]; p.cache2 = in[7];
    p.w_ada = in[8]; p.b_ada = in[9]; p.ln_g = in[10]; p.ln_b = in[11]; p.w_ffn_in = in[12]; p.w_ffn_out = in[13]; p.w_ret_in = in[14]; p.ret_gn_g = in[15]; p.ret_gn_b = in[16];
    p.w_ret_out = in[17]; p.w_att_in = in[18]; p.w_att_out = in[19];
    p.out = (float*)d_out; p.ctl = (unsigned*)(ws + wsm::CTL);
    p.wfi_t = (bf16*)(ws + wsm::WFI); p.wfo_t = (bf16*)(ws + wsm::WFO); p.wri_t = (bf16*)(ws + wsm::WRI); p.wro_t = (bf16*)(ws + wsm::WRO); p.wai_t = (bf16*)(ws + wsm::WAI); p.wao_t = (bf16*)(ws + wsm::WAO);
    p.wada_t = (bf16*)(ws + wsm::WADA); p.sc = (bf16*)(ws + wsm::SC); p.ada = (float*)(ws + wsm::ADA); p.X = (float*)(ws + wsm::X); p.Y = (float*)(ws + wsm::Y);
    p.XN = (bf16*)(ws + wsm::XN); p.H = (bf16*)(ws + wsm::H); p.QKV = (bf16*)(ws + wsm::QKV); p.AOB = (bf16*)(ws + wsm::AOB); p.OB = (bf16*)(ws + wsm::OB);
    p.U = (float*)(ws + wsm::U); p.SIN = (float*)(ws + wsm::SIN); p.PS = (float*)(ws + wsm::PS); p.ORET = (float*)(ws + wsm::ORET); p.OG = (float*)(ws + wsm::OG); p.LSE = (float*)(ws + wsm::LSE);
#if MK_ONE_LAUNCH
    a.ph_lo = 0; a.ph_hi = NPH;
    hipLaunchKernelGGL(fwd, dim3(grid), dim3(NT), LDS_BYTES, stream, a);
#else
    for (int ph = 0; ph < NPH; ++ph) {
        const int s = ph >= PH_L0 ? (ph - PH_L0) % PH_PER_LAYER : -1, L = ph >= PH_L0 ? (ph - PH_L0) / PH_PER_LAYER : -1;
        if (L == 1 && (s == S_MC || s == S_MD)) continue;
        a.ph_lo = ph; a.ph_hi = ph + 1;
        hipLaunchKernelGGL(fwd, dim3(grid), dim3(NT), LDS_BYTES, stream, a);
    }
#endif
    const hipError_t le = hipPeekAtLastError();
    if (le != hipSuccess) fprintf(stderr, "kernel_launch: launch failed: %s\n", hipGetErrorName(le));
}

#endif
```

```cpp
#ifndef HOST_SIM
#include <hip/hip_runtime.h>
#include <cstdio>
#include <cstdint>
#define HD __host__ __device__ __forceinline__
#else
#include <cmath>
#include <cstdio>
#include <cstdint>
#include <cstring>
#define HD inline
#endif

#ifndef CFG_D
#define CFG_D 1024
#define CFG_FF 2816
#define CFG_BATCH 2
#define CFG_SEQ 8192
#define CFG_DB 128
#define CFG_DS 4
#define CFG_PAST 2048
#define CFG_RH 4
#define CFG_RDK 256
#define CFG_RDV 512
#define CFG_RC 256
#define CFG_AH 8
#define CFG_AD 64
#define CFG_W0 128
#define CFG_DIL0 1
#define CFG_W1 512
#define CFG_DIL1 4
#define CFG_W2 2048
#define CFG_DIL2 16
#endif
namespace cfg {
constexpr int D = CFG_D, FF = CFG_FF, NFF = 2 * CFG_FF, BATCH = CFG_BATCH, SEQ = CFG_SEQ, DB = CFG_DB, DS = CFG_DS, PAST = CFG_PAST;
constexpr int MP = BATCH * SEQ, MS = DB * DS, M = MP + MS, NSEQ = BATCH + DB;
constexpr int RH = CFG_RH, RDK = CFG_RDK, RDV = CFG_RDV, RC = CFG_RC, QKW = RH * RDK, VW = RH * RDV, NRET = 2 * QKW + 2 * VW;
constexpr int NSEG = SEQ / RC, NITEM = BATCH * RH * NSEG;
constexpr int AH = CFG_AH, AD = CFG_AD, AO = AH * AD, NG = 3, NATT = 3 * NG * AO;
constexpr int SCR = ((NSEQ + 255) / 256) * 256;
constexpr int ADA_LD = 18 * D;
constexpr float LN_EPS = 1e-5f;
constexpr float ALPHA = 1.41421356237309515f;
HD int win(int g) { return g == 0 ? CFG_W0 : (g == 1 ? CFG_W1 : CFG_W2); }
HD int dil(int g) { return g == 0 ? CFG_DIL0 : (g == 1 ? CFG_DIL1 : CFG_DIL2); }
HD int nback(int g) { return win(g) / dil(g); }
HD int lbuf(int g) { return win(g) < PAST ? win(g) : PAST; }
HD int keep(int g) { return win(g) < SEQ ? win(g) : SEQ; }
constexpr long O_YP = 0, O_YS = O_YP + (long)MP * D, O_SRP = O_YS + (long)MS * D, O_SRS = O_SRP + (long)BATCH * RH * RDK * RDV, O_KV0 = O_SRS + (long)DB * RH * RDK * RDV;
}

typedef unsigned short bf16;
HD unsigned f2bf_u(float f) { unsigned u = __builtin_bit_cast(unsigned, f); return (u + 0x7fffu + ((u >> 16) & 1u)) >> 16; }
HD bf16 f2bf(float f) { return (bf16)f2bf_u(f); }
HD float bf2f(bf16 h) { unsigned u = (unsigned)h << 16; return __builtin_bit_cast(float, u); }
HD float silu_f(float x) { return x / (1.0f + expf(-x)); }
HD float swiglu_f(float a, float b) { return silu_f(a) * b; }
HD int seq_of_row(int m) { return m < cfg::MP ? m / cfg::SEQ : cfg::BATCH + (m - cfg::MP) / cfg::DS; }
HD float ret_log_gamma(int h) { return log1pf(-exp2f(-5.0f - (float)h)); }
HD float ret_pow(int h, float n) { return expf(n * ret_log_gamma(h)); }
HD float alibi_slope(int g, int head) { return exp2f(-8.0f * (float)(g * cfg::AH + head + 1) / (float)(cfg::NG * cfg::AH)); }
HD int ffn_dst_of_src(int c) { const int half = c / cfg::FF, j = c % cfg::FF; return 256 * (j / 128) + 128 * half + (j % 128); }
HD int ffn_src_of_dst(int r) { const int p = r / 256, rr = r % 256, half = rr / 128; return half * cfg::FF + 128 * p + rr % 128; }

struct Ptrs {
    const float *x_prompt, *x_sample, *c_prompt, *c_sample, *state_ret, *cache0, *cache1, *cache2, *w_ada, *b_ada, *ln_g, *ln_b, *w_ffn_in, *w_ffn_out, *w_ret_in, *ret_gn_g, *ret_gn_b, *w_ret_out, *w_att_in, *w_att_out;
    float* out;
    unsigned* ctl;
    bf16 *wfi_t, *wfo_t, *wri_t, *wro_t, *wai_t, *wao_t, *wada_t;
    bf16 *sc;
    float *ada;
    float *X, *Y;
    bf16 *XN, *H, *QKV, *AOB, *OB;
    float *U, *SIN, *PS, *ORET, *OG, *LSE;
};

HD const float* cache_ptr(const Ptrs& p, int g) { const uintptr_t m0 = (uintptr_t)0 - (uintptr_t)(g == 0), m1 = (uintptr_t)0 - (uintptr_t)(g == 1), m2 = (uintptr_t)0 - (uintptr_t)(g == 2); return (const float*)(((uintptr_t)p.cache0 & m0) | ((uintptr_t)p.cache1 & m1) | ((uintptr_t)p.cache2 & m2)); }
HD void it_silu_c(const Ptrs& p, long i) {
    using namespace cfg; const int r = (int)(i / D), k = (int)(i % D); float v = 0.f;
    if (r < NSEQ) v = silu_f(r < BATCH ? p.c_prompt[(long)r * D + k] : p.c_sample[(long)(r - BATCH) * D + k]);
    p.sc[i] = f2bf(v);
}
HD const float* ada_vec(const Ptrs& p, int seq, int layer, int j, int which) { return p.ada + (size_t)seq * cfg::ADA_LD + layer * 9 * cfg::D + (j * 3 + which) * cfg::D; }
HD void it_mod0(const Ptrs& p, long i) {
    using namespace cfg; const int m = (int)(i / D), c = (int)(i % D);
    const float x = m < MP ? p.x_prompt[i] : p.x_sample[i - (long)MP * D];
    const int s = seq_of_row(m);
    p.X[i] = x; p.XN[i] = f2bf(x * (1.0f + ada_vec(p, s, 0, 0, 1)[c]) + ada_vec(p, s, 0, 0, 0)[c]);
}
HD void it_ln_row(const Ptrs& p, int m, int layer, int j, float coef, int nl, int nj) {
    using namespace cfg; const int s = seq_of_row(m); const float* gate = ada_vec(p, s, layer, j, 2);
    float* X = p.X + (size_t)m * D; const float* Y = p.Y + (size_t)m * D;
    const float* lg = p.ln_g + (size_t)(layer * 3 + j) * D; const float* lb = p.ln_b + (size_t)(layer * 3 + j) * D;
    float sum = 0.f; for (int c = 0; c < D; ++c) sum += ALPHA * X[c] + coef * (1.0f + gate[c]) * Y[c];
    const float mu = sum / (float)D; float sq = 0.f;
    for (int c = 0; c < D; ++c) { const float z = ALPHA * X[c] + coef * (1.0f + gate[c]) * Y[c] - mu; sq += z * z; }
    const float rstd = 1.0f / sqrtf(sq / (float)D + LN_EPS);
    if (nj >= 0) { const float* sh = ada_vec(p, s, nl, nj, 0); const float* sc = ada_vec(p, s, nl, nj, 1); bf16* XN = p.XN + (size_t)m * D;
        for (int c = 0; c < D; ++c) { const float z = ALPHA * X[c] + coef * (1.0f + gate[c]) * Y[c]; const float xn = (z - mu) * rstd * lg[c] + lb[c]; X[c] = xn; XN[c] = f2bf(xn * (1.0f + sc[c]) + sh[c]); } }
    else { float* o = p.out + (size_t)m * D;
        for (int c = 0; c < D; ++c) { const float z = ALPHA * X[c] + coef * (1.0f + gate[c]) * Y[c]; o[c] = (z - mu) * rstd * lg[c] + lb[c]; } }
}
HD void ret_item(int it, int& n, int& h, int& seg) { using namespace cfg; n = it / (RH * NSEG); h = (it / NSEG) % RH; seg = it % NSEG; }
HD void it_ret_local(const Ptrs& p, long i) {
    using namespace cfg; const int it = (int)(i / (RDK * RDV)), d = (int)(i / RDV) % RDK, e = (int)(i % RDV); int n, h, seg; ret_item(it, n, h, seg);
    const size_t m0 = (size_t)n * SEQ + (size_t)seg * RC; const float ks = 1.0f / sqrtf((float)RDK); float acc = 0.f;
    for (int s = 0; s < RC; ++s) { const bf16* row = p.QKV + (m0 + s) * NRET; acc += ret_pow(h, (float)(RC - 1 - s)) * ks * bf2f(row[QKW + h * RDK + d]) * bf2f(row[2 * QKW + h * RDV + e]); }
    p.U[i] = acc;
}
HD void it_ret_scan(const Ptrs& p, long i) {
    using namespace cfg; const int nh = (int)(i / (RDK * RDV)); const long de = i % (RDK * RDV); const int h = nh % RH; const float cd = ret_pow(h, (float)RC); float S = 0.f;
    for (int seg = 0; seg < NSEG; ++seg) { const size_t o = ((size_t)nh * NSEG + seg) * (RDK * RDV) + de; p.SIN[o] = S; S = cd * S + p.U[o]; }
    p.out[O_SRP + i] = S;
}
HD void it_ret_scores(const Ptrs& p, long i) {
    using namespace cfg; const int it = (int)(i / (RC * RC)), t = (int)(i / RC) % RC, s = (int)(i % RC); int n, h, seg; ret_item(it, n, h, seg);
    float v = 0.f;
    if (s <= t) { const size_t m0 = (size_t)n * SEQ + (size_t)seg * RC; const bf16* q = p.QKV + (m0 + t) * NRET + h * RDK; const bf16* k = p.QKV + (m0 + s) * NRET + QKW + h * RDK; float acc = 0.f;
        for (int d = 0; d < RDK; ++d) acc += bf2f(q[d]) * bf2f(k[d]);
        v = acc * (1.0f / sqrtf((float)RDK)) * ret_pow(h, (float)(t - s)); }
    p.PS[i] = v;
}
HD void it_ret_out(const Ptrs& p, long i) {
    using namespace cfg; const int it = (int)(i / (RC * RDV)), t = (int)(i / RDV) % RC, e = (int)(i % RDV); int n, h, seg; ret_item(it, n, h, seg);
    const size_t m0 = (size_t)n * SEQ + (size_t)seg * RC; const float* P = p.PS + ((size_t)it * RC + t) * RC; float acc = 0.f;
    for (int s = 0; s <= t; ++s) acc += P[s] * bf2f(p.QKV[(m0 + s) * NRET + 2 * QKW + h * RDV + e]);
    const bf16* q = p.QKV + (m0 + t) * NRET + h * RDK; const float* S = p.SIN + (size_t)it * (RDK * RDV) + e; float a2 = 0.f;
    for (int d = 0; d < RDK; ++d) a2 += bf2f(q[d]) * S[(size_t)d * RDV];
    p.ORET[(m0 + t) * VW + h * RDV + e] = acc + ret_pow(h, (float)(t + 1)) * a2;
}
HD void it_rets_state(const Ptrs& p, long i) {
    using namespace cfg; const int nh = (int)(i / (RDK * RDV)), n = nh / RH, h = nh % RH, d = (int)(i / RDV) % RDK, e = (int)(i % RDV);
    const float ks = 1.0f / sqrtf((float)RDK); float acc = ret_pow(h, (float)DS) * p.state_ret[i];
    for (int s = 0; s < DS; ++s) { const bf16* row = p.QKV + ((size_t)MP + (size_t)n * DS + s) * NRET; acc += ret_pow(h, (float)(DS - 1 - s)) * ks * bf2f(row[QKW + h * RDK + d]) * bf2f(row[2 * QKW + h * RDV + e]); }
    p.out[O_SRS + i] = acc;
}
HD void it_rets_out(const Ptrs& p, long i) {
    using namespace cfg; const int ms = (int)(i / (RH * RDV)), h = (int)(i / RDV) % RH, e = (int)(i % RDV), n = ms / DS, t = ms % DS;
    const size_t r0 = (size_t)MP + (size_t)n * DS; const bf16* q = p.QKV + (r0 + t) * NRET + h * RDK; const float ks = 1.0f / sqrtf((float)RDK); float acc = 0.f;
    for (int s = 0; s <= t; ++s) { const bf16* k = p.QKV + (r0 + s) * NRET + QKW + h * RDK; float qk = 0.f; for (int d = 0; d < RDK; ++d) qk += bf2f(q[d]) * bf2f(k[d]);
        acc += qk * ks * ret_pow(h, (float)(t - s)) * bf2f(p.QKV[(r0 + s) * NRET + 2 * QKW + h * RDV + e]); }
    const float* S = p.state_ret + ((size_t)n * RH + h) * (RDK * RDV) + e; float a2 = 0.f;
    for (int d = 0; d < RDK; ++d) a2 += bf2f(q[d]) * S[(size_t)d * RDV];
    p.ORET[(r0 + t) * VW + h * RDV + e] = acc + ret_pow(h, (float)(t + 1)) * a2;
}
HD void it_ret_gate(const Ptrs& p, long i) {
    using namespace cfg; const size_t m = (size_t)(i / RH); const int h = (int)(i % RH); const float* o = p.ORET + m * VW + h * RDV; float sum = 0.f;
    for (int e = 0; e < RDV; ++e) sum += o[e];
    const float mu = sum / (float)RDV; float sq = 0.f; for (int e = 0; e < RDV; ++e) { const float z = o[e] - mu; sq += z * z; }
    const float rstd = 1.0f / sqrtf(sq / (float)RDV + LN_EPS); const bf16* g = p.QKV + m * NRET + 2 * QKW + VW + h * RDV;
    for (int e = 0; e < RDV; ++e) p.AOB[m * VW + h * RDV + e] = f2bf(silu_f(bf2f(g[e])) * ((o[e] - mu) * rstd * p.ret_gn_g[h * RDV + e] + p.ret_gn_b[h * RDV + e]));
}
HD void it_att(const Ptrs& p, long i) {
    using namespace cfg; const int dc = (int)(i % (AD / 8)), head = (int)(i / (AD / 8)) % AH, g = (int)(i / (AD / 8 * AH)) % NG; const int m = (int)(i / (AD / 8 * AH * NG));
    const int dl = dil(g), nb = nback(g), lb = lbuf(g); const float slope = alibi_slope(g, head) * (float)dl, scale = 1.0f / sqrtf((float)AD);
    const bf16* q = p.QKV + (size_t)m * NATT + g * AO + head * AD;
    float mx = -INFINITY, l = 0.f, a0 = 0.f, a1 = 0.f, a2 = 0.f, a3 = 0.f, a4 = 0.f, a5 = 0.f, a6 = 0.f, a7 = 0.f;
    const bool prompt = m < MP; const int t = prompt ? m % SEQ : (m - MP) % DS; const int nsmp = prompt ? 0 : (m - MP) / DS;
    for (int j = 0; j <= nb; ++j) {
        const bf16* kb = nullptr; const float* kf = nullptr;
        if (prompt) { const int pos = t - j * dl; if (pos < 0) break; kb = p.QKV + (size_t)(m - j * dl) * NATT + 3 * AO + g * AO + head * AD; }
        else { const int idx = lb + t - j * dl; if (idx < 0) break;
            if (idx >= lb) kb = p.QKV + ((size_t)MP + (size_t)nsmp * DS + (idx - lb)) * NATT + 3 * AO + g * AO + head * AD;
            else kf = cache_ptr(p, g) + (((size_t)nsmp * lb + idx) * 2) * AO + head * AD; }
        float sc = 0.f, v0, v1, v2, v3, v4, v5, v6, v7;
        if (kb) { for (int d = 0; d < AD; ++d) sc += bf2f(q[d]) * bf2f(kb[d]); const bf16* vb = kb + 3 * AO + dc * 8;
            v0 = bf2f(vb[0]); v1 = bf2f(vb[1]); v2 = bf2f(vb[2]); v3 = bf2f(vb[3]); v4 = bf2f(vb[4]); v5 = bf2f(vb[5]); v6 = bf2f(vb[6]); v7 = bf2f(vb[7]); }
        else { for (int d = 0; d < AD; ++d) sc += bf2f(q[d]) * kf[d]; const float* vf = kf + AO + dc * 8;
            v0 = vf[0]; v1 = vf[1]; v2 = vf[2]; v3 = vf[3]; v4 = vf[4]; v5 = vf[5]; v6 = vf[6]; v7 = vf[7]; }
        sc = sc * scale - slope * (float)j;
        const float mn = sc > mx ? sc : mx, f = expf(mx - mn), pj = expf(sc - mn);
        l = l * f + pj; mx = mn;
        a0 = a0 * f + pj * v0; a1 = a1 * f + pj * v1; a2 = a2 * f + pj * v2; a3 = a3 * f + pj * v3; a4 = a4 * f + pj * v4; a5 = a5 * f + pj * v5; a6 = a6 * f + pj * v6; a7 = a7 * f + pj * v7;
    }
    float* o = p.OG + ((size_t)g * M + m) * AO + head * AD + dc * 8; const float rl = 1.0f / l;
    o[0] = a0 * rl; o[1] = a1 * rl; o[2] = a2 * rl; o[3] = a3 * rl; o[4] = a4 * rl; o[5] = a5 * rl; o[6] = a6 * rl; o[7] = a7 * rl;
    if (dc == 0) p.LSE[((size_t)g * M + m) * AH + head] = mx + logf(l);
}
HD void it_att_merge(const Ptrs& p, long i) {
    using namespace cfg; const size_t m = (size_t)(i / AO); const int c = (int)(i % AO), head = c / AD;
    const float l0 = p.LSE[((size_t)0 * M + m) * AH + head], l1 = p.LSE[((size_t)1 * M + m) * AH + head], l2 = p.LSE[((size_t)2 * M + m) * AH + head];
    const float mx = fmaxf(l0, fmaxf(l1, l2)), w0 = expf(l0 - mx), w1 = expf(l1 - mx), w2 = expf(l2 - mx);
    const float acc = w0 * p.OG[((size_t)0 * M + m) * AO + c] + w1 * p.OG[((size_t)1 * M + m) * AO + c] + w2 * p.OG[((size_t)2 * M + m) * AO + c];
    p.OB[i] = f2bf(acc / (w0 + w1 + w2));
}
HD void it_kv_out(const Ptrs& p, long i) {
    using namespace cfg; long r = i;
    for (int g = 0; g < NG; ++g) {
        const long np = (long)BATCH * keep(g) * 2 * AO, ns = (long)MS * 2 * AO;
        if (r < np) { const int c = (int)(r % AO), kv = (int)(r / AO) % 2, row = (int)(r / (2 * AO)) % keep(g), n = (int)(r / ((long)2 * AO * keep(g)));
            const size_t m = (size_t)n * SEQ + (SEQ - keep(g)) + row; p.out[O_KV0 + i] = bf2f(p.QKV[m * NATT + (1 + kv) * 3 * AO + g * AO + c]); return; }
        r -= np;
        if (r < ns) { const int c = (int)(r % AO), kv = (int)(r / AO) % 2; const size_t m = (size_t)MP + (size_t)(r / (2 * AO)); p.out[O_KV0 + i] = bf2f(p.QKV[m * NATT + (1 + kv) * 3 * AO + g * AO + c]); return; }
        r -= ns;
    }
}
HD long kv_out_total() { using namespace cfg; long t = 0; for (int g = 0; g < NG; ++g) t += (long)BATCH * keep(g) * 2 * AO + (long)MS * 2 * AO; return t; }

#ifndef HOST_SIM
namespace pg8 {
#define PG8_LAS __attribute__((address_space(3)))
typedef unsigned short bf16_t;
typedef short bf16x8 __attribute__((ext_vector_type(8)));
typedef float f32x4 __attribute__((ext_vector_type(4)));
typedef unsigned u32x4 __attribute__((ext_vector_type(4)));
constexpr int BM = 256, BK = 64, HALF = 128, HTB = HALF * BK * 2  , STAGE_BYTES = 8 * HTB, NXCD = 8, WGM = 8;

__host__ __device__ __forceinline__ int lds_byte(int r, int c) { const int st = (r >> 4) * 2 + (c >> 5), rr = r & 15, cc = c & 31, ob = rr * 64 + cc * 2; return st * 1024 + (ob ^ (((ob >> 9) & 1) << 5)); }
__host__ __device__ __forceinline__ void stage_rc(int b, int& R, int& C) { const int st = b / 1024, sb = b % 1024, swz = sb ^ (((sb >> 9) & 1) << 5); R = (st >> 1) * 16 + swz / 64; C = (st & 1) * 32 + (swz % 64) / 2; }
__host__ __device__ __forceinline__ int perm32(int rho) { const int n = rho >> 4, i = rho & 15; return 8 * (i >> 2) + 4 * n + (i & 3); }

struct Unit { int pm, pn; };
struct Gemm { const bf16_t* A; const bf16_t* Bt; int M, N, K; };

struct StaticOrder {
    int nM, nN, nwg, G, c;
    __host__ __device__ void init(int M, int N, int G_, int c_) { nM = M / BM; nN = N / BM; nwg = nM * nN; G = G_; c = c_; }
    __host__ __device__ bool next(int i, Unit& u) const {
        const long L = (long)i * G + c; if (L >= nwg) return false;
        int wgid = (int)L; { const int q = nwg / NXCD, r = nwg % NXCD, xcd = wgid % NXCD, off = wgid / NXCD; wgid = (xcd < r ? xcd * (q + 1) : r * (q + 1) + (xcd - r) * q) + off; }
        const int nig = WGM * nN, gid = wgid / nig, fm = gid * WGM, gsz = (nM - fm) < WGM ? (nM - fm) : WGM;
        u.pm = fm + ((wgid % nig) % gsz); u.pn = (wgid % nig) / gsz; return true;
    }
    __device__ __forceinline__ void a_ready(const Unit&) const {}
    __device__ __forceinline__ void done(const Unit&) const {}
};

__device__ __forceinline__ unsigned cvt_pk_bf16(float lo, float hi) { unsigned r; asm volatile("v_cvt_pk_bf16_f32 %0, %1, %2" : "=v"(r) : "v"(lo), "v"(hi)); return r; }
typedef float f32x2 __attribute__((ext_vector_type(2)));
__device__ __forceinline__ f32x2 gelu_pk(f32x2 v) {
    const f32x2 av = __builtin_elementwise_abs(v), d = av * 0.2316418882f + 1.0f;
    f32x2 t; t.x = __builtin_amdgcn_rcpf(d.x); t.y = __builtin_amdgcn_rcpf(d.y);
    f32x2 q = t * 0.5307027145f + (-0.7265760135f); q = q * t + 0.7107068705f; q = q * t + (-0.142248368f); q = q * t + 0.127414796f; q = q * t;
    const f32x2 s = (v * v) * (-0.72134752044f);
    f32x2 e; e.x = __builtin_amdgcn_exp2f(s.x); e.y = __builtin_amdgcn_exp2f(s.y);
    const f32x2 m = v * (q * e), r = v - m;
    f32x2 o; o.x = v.x < 0.f ? m.x : r.x; o.y = v.y < 0.f ? m.y : r.y; return o;
}

template <int ACT  > struct EpiBf16 {
    static constexpr bool PERM = true, AFTER_DRAIN = false; static_assert(ACT == 0 || ACT == 1, "EpiBf16: ACT is 0 (none) or 1 (gelu_pk)");
    bf16_t* O; int ldc; const float* bias; int split_cols; size_t split_stride; float scale0;
    __device__ __forceinline__ void operator()(const f32x4 (&acc)[2][2][4][2], const Unit& u, int wr, int wc, int fr, int fq) const {
        const int row0 = u.pm * BM + wr * 64 + fr; int colt = u.pn * BM; bf16_t* base = O;
        float sc = 1.f; if (split_cols) { const int t = colt / split_cols; base += (size_t)t * split_stride; colt -= t * split_cols; if (t == 0) sc = scale0; }
        const int col0 = colt + wc * 32 + 8 * fq, bcol0 = u.pn * BM + wc * 32 + 8 * fq;
        f32x4 bv[2][2];
#pragma unroll
        for (int bj = 0; bj < 2; ++bj)
#pragma unroll
            for (int n = 0; n < 2; ++n) bv[bj][n] = bias ? *(const f32x4*)(bias + bcol0 + bj * HALF + 4 * n) : (f32x4){0.f, 0.f, 0.f, 0.f};
#pragma unroll
        for (int ai = 0; ai < 2; ++ai)
#pragma unroll
            for (int m = 0; m < 4; ++m) { bf16_t* rowp = base + (size_t)(row0 + ai * HALF + m * 16) * ldc + col0;
#pragma unroll
                for (int bj = 0; bj < 2; ++bj) { f32x4 v0 = acc[ai][bj][m][0] + bv[bj][0], v1 = acc[ai][bj][m][1] + bv[bj][1];
                    if (ACT == 1) { f32x2 a = gelu_pk((f32x2){v0[0], v0[1]}), b = gelu_pk((f32x2){v0[2], v0[3]}), c = gelu_pk((f32x2){v1[0], v1[1]}), d = gelu_pk((f32x2){v1[2], v1[3]});
                        v0 = (f32x4){a.x, a.y, b.x, b.y}; v1 = (f32x4){c.x, c.y, d.x, d.y}; }
                    v0 = v0 * sc; v1 = v1 * sc; u32x4 w; w.x = cvt_pk_bf16(v0[0], v0[1]); w.y = cvt_pk_bf16(v0[2], v0[3]); w.z = cvt_pk_bf16(v1[0], v1[1]); w.w = cvt_pk_bf16(v1[2], v1[3]);
                    *(u32x4*)(rowp + bj * HALF) = w; } }
    }
};

struct EpiF32 {
    static constexpr bool PERM = false, AFTER_DRAIN = false;
    float* C; int ldc; const float* bias;
    __device__ __forceinline__ void operator()(const f32x4 (&acc)[2][2][4][2], const Unit& u, int wr, int wc, int fr, int fq) const {
        const int row0 = u.pm * BM + wr * 64 + fr, col0 = u.pn * BM + wc * 32 + 4 * fq;
        f32x4 bv[2][2];
#pragma unroll
        for (int bj = 0; bj < 2; ++bj)
#pragma unroll
            for (int n = 0; n < 2; ++n) bv[bj][n] = bias ? *(const f32x4*)(bias + col0 + bj * HALF + n * 16) : (f32x4){0.f, 0.f, 0.f, 0.f};
#pragma unroll
        for (int ai = 0; ai < 2; ++ai)
#pragma unroll
            for (int m = 0; m < 4; ++m) { float* rowp = C + (size_t)(row0 + ai * HALF + m * 16) * ldc + col0;
#pragma unroll
                for (int bj = 0; bj < 2; ++bj)
#pragma unroll
                    for (int n = 0; n < 2; ++n) *(f32x4*)(rowp + bj * HALF + n * 16) = acc[ai][bj][m][n] + bv[bj][n]; }
    }
};
struct EpiSwiglu {
    static constexpr bool PERM = true, AFTER_DRAIN = false;
    bf16_t* O; int ldc;
    __device__ __forceinline__ void operator()(const f32x4 (&acc)[2][2][4][2], const Unit& u, int wr, int wc, int fr, int fq) const {
        const int row0 = u.pm * BM + wr * 64 + fr, col0 = u.pn * HALF + wc * 32 + 8 * fq;
#pragma unroll
        for (int ai = 0; ai < 2; ++ai)
#pragma unroll
            for (int m = 0; m < 4; ++m) { bf16_t* rowp = O + (size_t)(row0 + ai * HALF + m * 16) * ldc + col0;
                const f32x4 a0 = acc[ai][0][m][0], a1 = acc[ai][0][m][1], b0 = acc[ai][1][m][0], b1 = acc[ai][1][m][1];
                u32x4 w; w.x = cvt_pk_bf16(swiglu_f(a0[0], b0[0]), swiglu_f(a0[1], b0[1])); w.y = cvt_pk_bf16(swiglu_f(a0[2], b0[2]), swiglu_f(a0[3], b0[3]));
                w.z = cvt_pk_bf16(swiglu_f(a1[0], b1[0]), swiglu_f(a1[1], b1[1])); w.w = cvt_pk_bf16(swiglu_f(a1[2], b1[2]), swiglu_f(a1[3], b1[3]));
                *(u32x4*)rowp = w; }
    }
};
template <class Epi, class Sched, bool ALIGN_EPI = false, bool SP2 = false>
__device__ __forceinline__ void gemm_phase(PG8_LAS unsigned char* lds, const Gemm g, const Sched& S, const Epi& E) {
    const int tid = threadIdx.x, wid = __builtin_amdgcn_readfirstlane(tid >> 6), lane = tid & 63, wr = wid >> 2, wc = wid & 3, fr = lane & 15, fq = lane >> 4;
    const int K = g.K, nt = K / BK;
    unsigned voffA[2], voffB[2];
#pragma unroll
    for (int i = 0; i < 2; ++i) { int R, C; stage_rc(tid * 16 + i * 8192, R, C); const int Rb = Epi::PERM ? ((R & ~31) + perm32(R & 31)) : R;
        voffA[i] = (unsigned)(R * K + C) * 2u; voffB[i] = (unsigned)(Rb * K + C) * 2u; }
    const size_t kstep = (size_t)(BK * 2);
    const size_t hstep = (size_t)HALF * K * 2;
    const size_t tstep = 2 * hstep;
    const unsigned ldsw = (unsigned)wid * 1024u;
    const int aoff = lds_byte(wr * 64 + fr, fq * 8), boff = lds_byte(wc * 32 + fr, fq * 8);
#define PG8_SA(b, h) (((b) * 2 + (h)) * HTB)
#define PG8_SB(b, h) ((4 + (b) * 2 + (h)) * HTB)
#define PG8_STAGE(bufoff, gbase, voff) do { _Pragma("unroll") for (int _i = 0; _i < 2; ++_i) \
        __builtin_amdgcn_global_load_lds((const unsigned*)((const char*)(gbase) + (voff)[_i]), (PG8_LAS unsigned*)(lds + (bufoff) + ldsw + _i * 8192), 16, 0, 0); } while (0)
#define PG8_LDA(dst, b, h) do { _Pragma("unroll") for (int m = 0; m < 4; ++m) _Pragma("unroll") for (int k = 0; k < 2; ++k) dst[m][k] = *(const PG8_LAS bf16x8*)(lds + PG8_SA(b, h) + aoff + m * 2048 + k * 1024); } while (0)
#define PG8_LDB(dst, b, h) do { _Pragma("unroll") for (int n = 0; n < 2; ++n) _Pragma("unroll") for (int k = 0; k < 2; ++k) dst[n][k] = *(const PG8_LAS bf16x8*)(lds + PG8_SB(b, h) + boff + n * 2048 + k * 1024); } while (0)
#define PG8_MMA(ai, bj, At, Bt) do { __builtin_amdgcn_s_setprio(1); _Pragma("unroll") for (int m = 0; m < 4; ++m) _Pragma("unroll") for (int n = 0; n < 2; ++n) _Pragma("unroll") for (int k = 0; k < 2; ++k) \
        acc[ai][bj][m][n] = __builtin_amdgcn_mfma_f32_16x16x32_bf16(Bt[n][k], At[m][k], acc[ai][bj][m][n], 0, 0, 0); __builtin_amdgcn_s_setprio(0); } while (0)
#define PG8_WAIT_V(n) asm volatile("s_waitcnt vmcnt(" #n ")" ::: "memory")
#define PG8_WAIT_L(n) asm volatile("s_waitcnt lgkmcnt(" #n ")" ::: "memory")
#define PG8_BAR __builtin_amdgcn_s_barrier()
#define PG8_SCHED __builtin_amdgcn_sched_barrier(0)
    Unit cur, nxt; int ui = 0;
    if (!S.next(0, cur)) return;
    f32x4 acc[2][2][4][2];
#pragma unroll
    for (int a = 0; a < 2; ++a)
#pragma unroll
        for (int b = 0; b < 2; ++b)
#pragma unroll
            for (int m = 0; m < 4; ++m)
#pragma unroll
                for (int n = 0; n < 2; ++n) acc[a][b][m][n] = (f32x4){0.f, 0.f, 0.f, 0.f};
    bf16x8 At[4][2], B0[2][2], B1[2][2];
    const char* cA = (const char*)g.A + (size_t)cur.pm * tstep; const char* cB = (const char*)g.Bt + (size_t)cur.pn * tstep;
    S.a_ready(cur);
    if constexpr (SP2) {
        PG8_STAGE(PG8_SB(0, 0), cB, voffB); PG8_STAGE(PG8_SB(0, 1), cB + hstep, voffB); PG8_STAGE(PG8_SA(0, 0), cA, voffA); PG8_STAGE(PG8_SA(0, 1), cA + hstep, voffA);
        if (wr == 1) PG8_BAR;
        PG8_WAIT_V(2); PG8_BAR;
        PG8_STAGE(PG8_SB(1, 0), cB + kstep, voffB); PG8_STAGE(PG8_SA(1, 0), cA + kstep, voffA); PG8_STAGE(PG8_SB(1, 1), cB + hstep + kstep, voffB);
        PG8_WAIT_V(6); PG8_BAR;
    } else {
        PG8_STAGE(PG8_SB(0, 0), cB, voffB); PG8_STAGE(PG8_SA(0, 0), cA, voffA); PG8_STAGE(PG8_SB(0, 1), cB + hstep, voffB); PG8_STAGE(PG8_SA(0, 1), cA + hstep, voffA);
        if (wr == 1) PG8_BAR;
        PG8_WAIT_V(4); PG8_BAR;
        PG8_STAGE(PG8_SB(1, 0), cB + kstep, voffB); PG8_STAGE(PG8_SA(1, 0), cA + kstep, voffA); PG8_STAGE(PG8_SB(1, 1), cB + hstep + kstep, voffB);
        PG8_WAIT_V(6); PG8_BAR;
    }
    for (;;) {
        const bool has_next = S.next(ui + 1, nxt);
        const char* nA = has_next ? (const char*)g.A + (size_t)nxt.pm * tstep : cA; const char* nB = has_next ? (const char*)g.Bt + (size_t)nxt.pn * tstep : cB;
        for (int t = 0; t < nt; t += 2) {
            const bool last = (t == nt - 2);
            const char* a1 = cA + (size_t)(t + 1) * kstep;
            const char* a2 = last ? nA : cA + (size_t)(t + 2) * kstep; const char* b2 = last ? nB : cB + (size_t)(t + 2) * kstep;
            const char* a3 = a2 + kstep; const char* b3 = b2 + kstep;
            if (last && has_next) S.a_ready(nxt);
            if constexpr (SP2) {
            PG8_LDB(B0, 0, 0); PG8_LDB(B1, 0, 1); PG8_SCHED; PG8_LDA(At, 0, 0); PG8_STAGE(PG8_SA(1, 1), a1 + hstep, voffA);
            PG8_WAIT_V(8); PG8_WAIT_L(0); PG8_BAR; PG8_MMA(0, 0, At, B0); PG8_MMA(0, 1, At, B1); PG8_BAR; PG8_SCHED;
            PG8_LDA(At, 0, 1); PG8_STAGE(PG8_SB(0, 0), b2, voffB); PG8_STAGE(PG8_SB(0, 1), b2 + hstep, voffB); PG8_STAGE(PG8_SA(0, 0), a2, voffA);
            PG8_WAIT_V(8); PG8_WAIT_L(0); PG8_BAR; PG8_MMA(1, 0, At, B0); PG8_MMA(1, 1, At, B1); PG8_BAR; PG8_SCHED;
            PG8_LDB(B0, 1, 0); PG8_LDB(B1, 1, 1); PG8_SCHED; PG8_LDA(At, 1, 0); PG8_STAGE(PG8_SA(0, 1), a2 + hstep, voffA);
            PG8_WAIT_V(8); PG8_WAIT_L(0); PG8_BAR; PG8_MMA(0, 0, At, B0); PG8_MMA(0, 1, At, B1); PG8_BAR; PG8_SCHED;
            PG8_LDA(At, 1, 1); PG8_STAGE(PG8_SB(1, 0), b3, voffB); PG8_STAGE(PG8_SB(1, 1), b3 + hstep, voffB); PG8_STAGE(PG8_SA(1, 0), a3, voffA);
            PG8_WAIT_V(8); PG8_WAIT_L(0); PG8_BAR; PG8_MMA(1, 0, At, B0); PG8_MMA(1, 1, At, B1); PG8_BAR; PG8_SCHED;
            } else {
            PG8_LDB(B0, 0, 0); PG8_SCHED; PG8_LDA(At, 0, 0); PG8_STAGE(PG8_SA(1, 1), a1 + hstep, voffA);
            PG8_WAIT_L(8); PG8_BAR; PG8_WAIT_L(0); PG8_MMA(0, 0, At, B0); PG8_BAR; PG8_SCHED;
            PG8_LDB(B1, 0, 1); PG8_STAGE(PG8_SB(0, 0), b2, voffB);
            PG8_BAR; PG8_WAIT_L(0); PG8_MMA(0, 1, At, B1); PG8_BAR;
            PG8_LDA(At, 0, 1); PG8_STAGE(PG8_SA(0, 0), a2, voffA);
            PG8_BAR; PG8_WAIT_L(0); PG8_MMA(1, 0, At, B0); PG8_BAR; PG8_SCHED;
            PG8_STAGE(PG8_SB(0, 1), b2 + hstep, voffB);
            PG8_WAIT_V(6); PG8_BAR; PG8_MMA(1, 1, At, B1); PG8_BAR;
            PG8_LDB(B0, 1, 0); PG8_SCHED; PG8_LDA(At, 1, 0); PG8_STAGE(PG8_SA(0, 1), a2 + hstep, voffA);
            PG8_WAIT_L(8); PG8_BAR; PG8_WAIT_L(0); PG8_MMA(0, 0, At, B0); PG8_BAR; PG8_SCHED;
            PG8_LDB(B1, 1, 1); PG8_STAGE(PG8_SB(1, 0), b3, voffB);
            PG8_BAR; PG8_WAIT_L(0); PG8_MMA(0, 1, At, B1); PG8_BAR;
            PG8_LDA(At, 1, 1); PG8_STAGE(PG8_SA(1, 0), a3, voffA);
            PG8_BAR; PG8_WAIT_L(0); PG8_MMA(1, 0, At, B0); PG8_BAR; PG8_SCHED;
            PG8_STAGE(PG8_SB(1, 1), b3 + hstep, voffB);
            PG8_WAIT_V(6); PG8_BAR; PG8_MMA(1, 1, At, B1); PG8_BAR;
            }
        }
        if constexpr (ALIGN_EPI) { if (wr == 0) PG8_BAR; }
        if constexpr (!Epi::AFTER_DRAIN) { E(acc, cur, wr, wc, fr, fq); S.done(cur); }
        if (!has_next) break;
#pragma unroll
        for (int a = 0; a < 2; ++a)
#pragma unroll
            for (int b = 0; b < 2; ++b)
#pragma unroll
                for (int m = 0; m < 4; ++m)
#pragma unroll
                    for (int n = 0; n < 2; ++n) acc[a][b][m][n] = (f32x4){0.f, 0.f, 0.f, 0.f};
        cur = nxt; cA = nA; cB = nB; ++ui;
        if constexpr (ALIGN_EPI) { if (wr == 1) PG8_BAR; }
    }
    PG8_WAIT_V(0);
    if constexpr (!ALIGN_EPI) { if (wr == 0) PG8_BAR; }
    PG8_BAR;
    if constexpr (Epi::AFTER_DRAIN) { E.fused(acc, cur, wr, wc, fr, fq, lds, wid, lane); S.done(cur); }
#undef PG8_SA
#undef PG8_SB
#undef PG8_STAGE
#undef PG8_LDA
#undef PG8_LDB
#undef PG8_MMA
#undef PG8_WAIT_V
#undef PG8_WAIT_L
#undef PG8_BAR
#undef PG8_SCHED
}
}

#define GAS __attribute__((address_space(1)))
#define LAS __attribute__((address_space(3)))
typedef unsigned v4u __attribute__((ext_vector_type(4)));
typedef float f32x4 __attribute__((ext_vector_type(4)));
typedef short bf16x8 __attribute__((ext_vector_type(8)));
typedef GAS unsigned gu32;
typedef GAS unsigned long long gu64;
#define RLX_AGENT __ATOMIC_RELAXED, __HIP_MEMORY_SCOPE_AGENT
#define LDS_WAIT() asm volatile("s_waitcnt lgkmcnt(0)" ::: "memory")
#define VM_WAIT() asm volatile("s_waitcnt vmcnt(0)" ::: "memory")
__device__ __forceinline__ unsigned long long rt() { return __builtin_amdgcn_s_memrealtime(); }
__device__ __forceinline__ unsigned pk2(float lo, float hi) { return f2bf_u(lo) | (f2bf_u(hi) << 16); }

#define XB_TMO      128
#define XB_XCNT(j)  (256  + 64 * (j))
#define XB_XSUB(j)  (1280 + 64 * (j))
#define XB_XGEN(j)  (2304 + 64 * (j))
#define XB_TOP      3328
#define XB_TOPGEN   3392
#define XCD_BAR_WORDS 3456
#define XB_SPIN_CAP (1u << 18)

__device__ __forceinline__ unsigned xb_ld(unsigned* p)              { return __hip_atomic_load(p, __ATOMIC_RELAXED, __HIP_MEMORY_SCOPE_AGENT); }
__device__ __forceinline__ unsigned xb_add(unsigned* p, unsigned v) { return __hip_atomic_fetch_add(p, v, __ATOMIC_RELAXED, __HIP_MEMORY_SCOPE_AGENT); }
__device__ __forceinline__ unsigned xb_xcc_id() { return (unsigned)__builtin_amdgcn_s_getreg((3 << 11) | 20) & 0xFu; }
#define XB_SPIN(cond, bar) do { unsigned _sp = 0; while (cond) { __builtin_amdgcn_s_sleep(1); \
    if ((++_sp & 255u) == 0u) { if (xb_ld(&(bar)[XB_TMO])) break; if (_sp > XB_SPIN_CAP) { atomicAdd(&(bar)[XB_TMO], 1u); break; } } } } while (0)

struct XcdBarrier {
    unsigned* bar; unsigned x;
    volatile LAS unsigned* st;
};

__device__ __forceinline__ XcdBarrier xcd_barrier_post(unsigned* bar, volatile LAS unsigned* st) {
    XcdBarrier b; b.bar = bar; b.x = xb_xcc_id(); b.st = st;
    if (threadIdx.x == 0) (void)xb_add(&bar[XB_XCNT(b.x)], 1u);
    return b;
}
__device__ __forceinline__ void xcd_barrier_complete(unsigned* bar, unsigned x, unsigned& nloc, unsigned& nx) {
    const unsigned G = gridDim.x * gridDim.y * gridDim.z;
    unsigned sum, cnt, mine, sp = 0u;
    for (;;) {
        sum = 0u; cnt = 0u; mine = 0u;
#pragma unroll
        for (unsigned j = 0; j < 16; ++j) { const unsigned c = xb_ld(&bar[XB_XCNT(j)]); sum += c; cnt += (c > 0u) ? 1u : 0u; mine = (j == x) ? c : mine; }
        if (sum == G) break;
        __builtin_amdgcn_s_sleep(1);
        if ((++sp & 255u) == 0u) { if (xb_ld(&bar[XB_TMO])) break; if (sp > XB_SPIN_CAP) { atomicAdd(&bar[XB_TMO], 1u); break; } }
    }
    nloc = mine > 0u ? mine : 1u; nx = cnt > 0u ? cnt : 1u;
}

__device__ __forceinline__ void xcd_barrier(const XcdBarrier& b) {
    asm volatile("s_waitcnt vmcnt(0)" ::: "memory");
    __syncthreads();
    if (threadIdx.x == 0) {
        unsigned* bar = b.bar;
        __builtin_amdgcn_s_waitcnt(0);
        unsigned nloc = b.st[0], nx = b.st[1];
        if (nloc == 0u) { xcd_barrier_complete(bar, b.x, nloc, nx); b.st[0] = nloc; b.st[1] = nx; }
        const unsigned old = xb_add(&bar[XB_XSUB(b.x)], 1u);
        const unsigned gen = old / nloc;
        if (old + 1u == (gen + 1u) * nloc) {
            __builtin_amdgcn_fence(__ATOMIC_RELEASE, "agent");
            asm volatile("s_waitcnt vmcnt(0)" ::: "memory");
            const unsigned og = xb_add(&bar[XB_TOP], 1u);
            const unsigned tg = og / nx;
            if (og + 1u == (tg + 1u) * nx) xb_add(&bar[XB_TOPGEN], 1u);
            else XB_SPIN(xb_ld(&bar[XB_TOPGEN]) == tg, bar);
            __builtin_amdgcn_fence(__ATOMIC_ACQUIRE, "agent");
            xb_add(&bar[XB_XGEN(b.x)], 1u);
            asm volatile("s_waitcnt vmcnt(0)" ::: "memory");
        } else {
            XB_SPIN(xb_ld(&bar[XB_XGEN(b.x)]) == gen, bar);
            __builtin_amdgcn_fence(__ATOMIC_ACQUIRE, "agent");
            asm volatile("s_waitcnt vmcnt(0)" ::: "memory");
        }
    }
    __syncthreads();
}

constexpr int NWAVES = 8, NT = NWAVES * 64;
#ifndef MK_ONE_LAUNCH
#define MK_ONE_LAUNCH 1
#endif
constexpr int PH_PRO = 0, PH_ADA = 1, PH_MOD0 = 2, PH_L0 = 3, PH_PER_LAYER = 13, NPH = PH_L0 + 2 * PH_PER_LAYER;
enum Slot { S_G1A = 0, S_G2A, S_LNA, S_MIN, S_MA, S_MB, S_MC, S_MD, S_MOUT, S_LNM, S_G1B, S_G2B, S_LNB };
namespace wsm {
using namespace cfg;
constexpr size_t al(size_t x) { return (x + 4095) & ~(size_t)4095; }
constexpr size_t CTL = 0, CTL_BYTES = 1u << 20;
constexpr size_t WFI = al(CTL + CTL_BYTES);
constexpr size_t WFO = al(WFI + (size_t)4 * NFF * D * 2);
constexpr size_t WRI = al(WFO + (size_t)4 * D * FF * 2);
constexpr size_t WRO = al(WRI + (size_t)NRET * D * 2);
constexpr size_t WAI = al(WRO + (size_t)D * VW * 2);
constexpr size_t WAO = al(WAI + (size_t)NATT * D * 2);
constexpr size_t WADA = al(WAO + (size_t)D * AO * 2);
constexpr size_t SC = al(WADA + (size_t)18 * D * D * 2);
constexpr size_t ADA = al(SC + (size_t)SCR * D * 2);
constexpr size_t X = al(ADA + (size_t)SCR * ADA_LD * 4);
constexpr size_t Y = al(X + (size_t)M * D * 4);
constexpr size_t XN = al(Y + (size_t)M * D * 4);
constexpr size_t H = al(XN + (size_t)M * D * 2);
constexpr size_t QKV = al(H + (size_t)M * FF * 2);
constexpr size_t AOB = al(QKV + (size_t)M * NRET * 2);
constexpr size_t OB = al(AOB + (size_t)M * VW * 2);
constexpr size_t U = al(OB + (size_t)M * AO * 2);
constexpr size_t SIN = al(U + (size_t)NITEM * RDK * RDV * 4);
constexpr size_t PS = al(SIN + (size_t)NITEM * RDK * RDV * 4);
constexpr size_t ORET = al(PS + (size_t)NITEM * RC * RC * 4);
constexpr size_t OG = al(ORET + (size_t)M * VW * 4);
constexpr size_t LSE = al(OG + (size_t)3 * M * AO * 4);
constexpr size_t END = al(LSE + (size_t)3 * M * AH * 4);
static_assert(NRET >= NATT, "QKV buffer is sized by the retention projection");
}
constexpr int CW_TMO = 0, CW_CODE = 1, CW_BAR = 4096;
constexpr int RING_OFF = 0, RING_BYTES = 131072;
constexpr int LDSCTL_OFF = RING_BYTES, MISC_OFF = LDSCTL_OFF + 320;
constexpr int LDS_BYTES = 147456;

struct Args { Ptrs p; int ph_lo, ph_hi; };

__device__ __forceinline__ const Args* kargs() { auto k = __builtin_amdgcn_kernarg_segment_ptr(); asm volatile("" : "+s"(k)); return (const Args*)k; }
#define GRID_ITEMS(total, call) do { const long _tot = (long)(total); for (long _i = (long)blockIdx.x * NT + threadIdx.x; _i < _tot; _i += (long)gridDim.x * NT) { call; } } while (0)

__device__ __forceinline__ void p0_transpose_item(const float* W, int K, int N, bf16* WT, int ffn, int row_off, LAS float* scr, int item, int lane) {
    const int nblk = N / 32, kb = item / nblk, nb = item % nblk, k0 = 64 * kb, n0 = 32 * nb;
    const int dst0 = ffn ? ffn_dst_of_src(n0) : row_off + n0;
#pragma unroll 8
    for (int i = 0; i < 32; ++i) { const int kk = 2 * i + (lane >> 5); scr[kk * 33 + (lane & 31)] = W[(size_t)(k0 + kk) * N + n0 + (lane & 31)]; }
    LDS_WAIT(); asm volatile("" ::: "memory");
    const int c = lane & 7;
#pragma unroll
    for (int j = 0; j < 4; ++j) { const int n = (lane >> 3) + 8 * j; const LAS float* s = scr + (8 * c) * 33 + n;
        v4u o; o.x = pk2(s[0 * 33], s[1 * 33]); o.y = pk2(s[2 * 33], s[3 * 33]); o.z = pk2(s[4 * 33], s[5 * 33]); o.w = pk2(s[6 * 33], s[7 * 33]);
        *(GAS v4u*)(WT + (size_t)(dst0 + n) * K + k0 + 8 * c) = o; }
    LDS_WAIT(); asm volatile("" ::: "memory");
}
__device__ __forceinline__ void p0_prologue(const Ptrs& p, LAS unsigned char* lds, int wave, int lane) {
    using namespace cfg;
    LAS float* scr = (LAS float*)(lds + RING_OFF + wave * 16384);
    const int gw = blockIdx.x * NWAVES + wave, NGW = gridDim.x * NWAVES;
    constexpr int I_FI = (D / 64) * (NFF / 32), I_FO = (FF / 64) * (D / 32), I_RI = (D / 64) * (NRET / 32), I_RO = (VW / 64) * (D / 32), I_AI = (D / 64) * (NATT / 32), I_AO = (AO / 64) * (D / 32), I_AD = (D / 64) * (9 * D / 32);
    constexpr int NITEMS = 4 * I_FI + 4 * I_FO + I_RI + I_RO + I_AI + I_AO + 2 * I_AD;
    for (int it = gw; it < NITEMS; it += NGW) {
        int r = it;
        if (r < 4 * I_FI) { const int w = r / I_FI; p0_transpose_item(p.w_ffn_in + (size_t)w * D * NFF, D, NFF, p.wfi_t + (size_t)w * NFF * D, 1, 0, scr, r % I_FI, lane); continue; } r -= 4 * I_FI;
        if (r < 4 * I_FO) { const int w = r / I_FO; p0_transpose_item(p.w_ffn_out + (size_t)w * FF * D, FF, D, p.wfo_t + (size_t)w * D * FF, 0, 0, scr, r % I_FO, lane); continue; } r -= 4 * I_FO;
        if (r < I_RI) { p0_transpose_item(p.w_ret_in, D, NRET, p.wri_t, 0, 0, scr, r, lane); continue; } r -= I_RI;
        if (r < I_RO) { p0_transpose_item(p.w_ret_out, VW, D, p.wro_t, 0, 0, scr, r, lane); continue; } r -= I_RO;
        if (r < I_AI) { p0_transpose_item(p.w_att_in, D, NATT, p.wai_t, 0, 0, scr, r, lane); continue; } r -= I_AI;
        if (r < I_AO) { p0_transpose_item(p.w_att_out, AO, D, p.wao_t, 0, 0, scr, r, lane); continue; } r -= I_AO;
        { const int w = r / I_AD; p0_transpose_item(p.w_ada + (size_t)w * D * 9 * D, D, 9 * D, p.wada_t, 0, w * 9 * D, scr, r % I_AD, lane); }
    }
    GRID_ITEMS((long)SCR * D, it_silu_c(p, _i));
}

#define IN(k) (lo <= (k) && (k) < hi)
#define SEAM(k) do { if (MK_ONE_LAUNCH && IN((k) + 1)) xcd_barrier(bar); } while (0)
template <int L> __device__ __forceinline__ void layer_phases(LAS unsigned char* lds, const XcdBarrier& bar, const int lo, const int hi, const int G) {
    using namespace cfg;
    constexpr int base = PH_L0 + PH_PER_LAYER * L;

        if (IN(base + S_G1A)) { const Ptrs p = kargs()->p;
            pg8::Gemm g{p.XN, p.wfi_t + (size_t)(L * 2 + 0) * NFF * D, M, NFF, D}; pg8::StaticOrder S; S.init(M, NFF, G, (int)blockIdx.x);
            pg8::EpiSwiglu E{p.H, FF};
            pg8::gemm_phase<pg8::EpiSwiglu, pg8::StaticOrder, true, true>(lds + RING_OFF, g, S, E);
            SEAM(base + S_G1A);
        }
        if (IN(base + S_G2A)) { const Ptrs p = kargs()->p;
            pg8::Gemm g{p.H, p.wfo_t + (size_t)(L * 2 + 0) * D * FF, M, D, FF}; pg8::StaticOrder S; S.init(M, D, G, (int)blockIdx.x);
            pg8::EpiF32 E{p.Y, D, nullptr};
            pg8::gemm_phase<pg8::EpiF32, pg8::StaticOrder, true, true>(lds + RING_OFF, g, S, E);
            SEAM(base + S_G2A);
        }
        if (IN(base + S_LNA)) { const Ptrs p = kargs()->p; GRID_ITEMS(M, it_ln_row(p, (int)_i, L, 0, 0.5f, L, 1)); SEAM(base + S_LNA); }
        if constexpr (L == 0) {
            if (IN(base + S_MIN)) { const Ptrs p = kargs()->p;
                pg8::Gemm g{p.XN, p.wri_t, M, NRET, D}; pg8::StaticOrder S; S.init(M, NRET, G, (int)blockIdx.x);
                pg8::EpiBf16<0> E{p.QKV, NRET, nullptr, 0, 0, 1.f};
                pg8::gemm_phase<pg8::EpiBf16<0>, pg8::StaticOrder, true, true>(lds + RING_OFF, g, S, E);
                SEAM(base + S_MIN);
            }
            if (IN(base + S_MA)) { const Ptrs p = kargs()->p;
                GRID_ITEMS((long)NITEM * RDK * RDV, it_ret_local(p, _i));
                GRID_ITEMS((long)NITEM * RC * RC, it_ret_scores(p, _i));
                GRID_ITEMS((long)DB * RH * RDK * RDV, it_rets_state(p, _i));
                GRID_ITEMS((long)MS * RH * RDV, it_rets_out(p, _i));
                SEAM(base + S_MA);
            }
            if (IN(base + S_MB)) { const Ptrs p = kargs()->p; GRID_ITEMS((long)BATCH * RH * RDK * RDV, it_ret_scan(p, _i)); SEAM(base + S_MB); }
            if (IN(base + S_MC)) { const Ptrs p = kargs()->p; GRID_ITEMS((long)NITEM * RC * RDV, it_ret_out(p, _i)); SEAM(base + S_MC); }
            if (IN(base + S_MD)) { const Ptrs p = kargs()->p; GRID_ITEMS((long)M * RH, it_ret_gate(p, _i)); SEAM(base + S_MD); }
            if (IN(base + S_MOUT)) { const Ptrs p = kargs()->p;
                pg8::Gemm g{p.AOB, p.wro_t, M, D, VW}; pg8::StaticOrder S; S.init(M, D, G, (int)blockIdx.x);
                pg8::EpiF32 E{p.Y, D, nullptr};
                pg8::gemm_phase<pg8::EpiF32, pg8::StaticOrder, true, true>(lds + RING_OFF, g, S, E);
                SEAM(base + S_MOUT);
            }
        } else {
            if (IN(base + S_MIN)) { const Ptrs p = kargs()->p;
                pg8::Gemm g{p.XN, p.wai_t, M, NATT, D}; pg8::StaticOrder S; S.init(M, NATT, G, (int)blockIdx.x);
                pg8::EpiBf16<0> E{p.QKV, NATT, nullptr, 0, 0, 1.f};
                pg8::gemm_phase<pg8::EpiBf16<0>, pg8::StaticOrder, true, true>(lds + RING_OFF, g, S, E);
                SEAM(base + S_MIN);
            }
            if (IN(base + S_MA)) { const Ptrs p = kargs()->p;
                GRID_ITEMS((long)M * NG * AH * (AD / 8), it_att(p, _i));
                GRID_ITEMS(kv_out_total(), it_kv_out(p, _i));
                SEAM(base + S_MA);
            }
            if (IN(base + S_MB)) { const Ptrs p = kargs()->p; GRID_ITEMS((long)M * AO, it_att_merge(p, _i)); SEAM(base + S_MB + 2); }
            if (IN(base + S_MOUT)) { const Ptrs p = kargs()->p;
                pg8::Gemm g{p.OB, p.wao_t, M, D, AO}; pg8::StaticOrder S; S.init(M, D, G, (int)blockIdx.x);
                pg8::EpiF32 E{p.Y, D, nullptr};
                pg8::gemm_phase<pg8::EpiF32, pg8::StaticOrder, true, true>(lds + RING_OFF, g, S, E);
                SEAM(base + S_MOUT);
            }
        }
        if (IN(base + S_LNM)) { const Ptrs p = kargs()->p; GRID_ITEMS(M, it_ln_row(p, (int)_i, L, 1, 1.0f, L, 2)); SEAM(base + S_LNM); }
        if (IN(base + S_G1B)) { const Ptrs p = kargs()->p;
            pg8::Gemm g{p.XN, p.wfi_t + (size_t)(L * 2 + 1) * NFF * D, M, NFF, D}; pg8::StaticOrder S; S.init(M, NFF, G, (int)blockIdx.x);
            pg8::EpiSwiglu E{p.H, FF};
            pg8::gemm_phase<pg8::EpiSwiglu, pg8::StaticOrder, true, true>(lds + RING_OFF, g, S, E);
            SEAM(base + S_G1B);
        }
        if (IN(base + S_G2B)) { const Ptrs p = kargs()->p;
            pg8::Gemm g{p.H, p.wfo_t + (size_t)(L * 2 + 1) * D * FF, M, D, FF}; pg8::StaticOrder S; S.init(M, D, G, (int)blockIdx.x);
            pg8::EpiF32 E{p.Y, D, nullptr};
            pg8::gemm_phase<pg8::EpiF32, pg8::StaticOrder, true, true>(lds + RING_OFF, g, S, E);
            SEAM(base + S_G2B);
        }
        if (IN(base + S_LNB)) { const Ptrs p = kargs()->p; GRID_ITEMS(M, it_ln_row(p, (int)_i, L, 2, 0.5f, L + 1, L == 0 ? 0 : -1)); SEAM(base + S_LNB); }
    }
#undef IN
#undef SEAM
__global__ void __launch_bounds__(NT, 2) fwd(Args args) {
    using namespace cfg;
    extern __shared__ __attribute__((aligned(16))) unsigned char lds_raw[];
    LAS unsigned char* lds = (LAS unsigned char*)lds_raw;
    volatile LAS unsigned* MISC = (volatile LAS unsigned*)(lds + MISC_OFF);
    const int tid = threadIdx.x, lane = tid & 63, wave = __builtin_amdgcn_readfirstlane(tid >> 6);
    const int G = gridDim.x;
    for (int u = tid; u < (LDS_BYTES - LDSCTL_OFF) / 4; u += NT) ((LAS unsigned*)(lds + LDSCTL_OFF))[u] = 0u;
    __syncthreads();
    XcdBarrier bar; { unsigned* const ctl = kargs()->p.ctl; bar.bar = ctl + CW_BAR; bar.x = 0; bar.st = nullptr;
    if (MK_ONE_LAUNCH) bar = xcd_barrier_post(ctl + CW_BAR, MISC + 8); }
    const int lo = args.ph_lo, hi = args.ph_hi;
#define IN(k) (lo <= (k) && (k) < hi)
#define SEAM(k) do { if (MK_ONE_LAUNCH && IN((k) + 1)) xcd_barrier(bar); } while (0)

    if (IN(PH_PRO)) { const Ptrs p = kargs()->p; p0_prologue(p, lds, wave, lane); SEAM(PH_PRO); }
    if (IN(PH_ADA)) { const Ptrs p = kargs()->p;
        pg8::Gemm g{p.sc, p.wada_t, SCR, 18 * D, D}; pg8::StaticOrder S; S.init(SCR, 18 * D, G, (int)blockIdx.x);
        pg8::EpiF32 E{p.ada, ADA_LD, p.b_ada};
        pg8::gemm_phase<pg8::EpiF32, pg8::StaticOrder, true, true>(lds + RING_OFF, g, S, E);
        SEAM(PH_ADA);
    }
    if (IN(PH_MOD0)) { const Ptrs p = kargs()->p; GRID_ITEMS((long)M * D, it_mod0(p, _i)); SEAM(PH_MOD0); }

    layer_phases<0>(lds, bar, lo, hi, G);
    layer_phases<1>(lds, bar, lo, hi, G);
#undef IN
#undef SEAM
}

extern "C" void kernel_launch(void* const* d_in, const int* in_sizes, int n_in, void* d_out, int out_size, void* d_ws, size_t ws_size, hipStream_t stream) {
    using namespace cfg;
    static int grid = 0;
    if (grid == 0) {
        const long want_out = O_KV0 + kv_out_total();
        if (n_in != 20 || (long)out_size != want_out || ws_size < wsm::END) { fprintf(stderr, "kernel_launch: shape mismatch: n_in %d out %d (want %ld) ws %zu (want %zu); nothing launched\n", n_in, out_size, want_out, ws_size, (size_t)wsm::END); grid = -1; return; }
        int dev = 0, cus = 0, per_cu = 0;
        if (hipGetDevice(&dev) != hipSuccess || hipDeviceGetAttribute(&cus, hipDeviceAttributeMultiprocessorCount, dev) != hipSuccess) { grid = -1; return; }
        if (hipFuncSetAttribute((const void*)fwd, hipFuncAttributeMaxDynamicSharedMemorySize, LDS_BYTES) != hipSuccess) { fprintf(stderr, "kernel_launch: hipFuncSetAttribute failed\n"); grid = -1; return; }
        if (hipOccupancyMaxActiveBlocksPerMultiprocessor(&per_cu, (const void*)fwd, NT, LDS_BYTES) != hipSuccess || per_cu < 1) fprintf(stderr, "kernel_launch: note: occupancy query reports %d workgroups per CU\n", per_cu);
        (void)hipGetLastError();
        grid = cus;
    }
    if (grid < 0) return;
    unsigned char* ws = (unsigned char*)d_ws;
    if (hipMemsetAsync(ws + wsm::CTL, 0, wsm::CTL_BYTES, stream) != hipSuccess) return;
    Args a{};
    Ptrs& p = a.p; const float* const* in = (const float* const*)d_in;
    p.x_prompt = in[0]; p.x_sample = in[1]; p.c_prompt = in[2]; p.c_sample = in[3]; p.state_ret = in[4]; p.cache0 = in[5]; p.cache1 = in[6]; p.cache2 = in[7];
    p.w_ada = in[8]; p.b_ada = in[9]; p.ln_g = in[10]; p.ln_b = in[11]; p.w_ffn_in = in[12]; p.w_ffn_out = in[13]; p.w_ret_in = in[14]; p.ret_gn_g = in[15]; p.ret_gn_b = in[16];
    p.w_ret_out = in[17]; p.w_att_in = in[18]; p.w_att_out = in[19];
    p.out = (float*)d_out; p.ctl = (unsigned*)(ws + wsm::CTL);
    p.wfi_t = (bf16*)(ws + wsm::WFI); p.wfo_t = (bf16*)(ws + wsm::WFO); p.wri_t = (bf16*)(ws + wsm::WRI); p.wro_t = (bf16*)(ws + wsm::WRO); p.wai_t = (bf16*)(ws + wsm::WAI); p.wao_t = (bf16*)(ws + wsm::WAO);
    p.wada_t = (bf16*)(ws + wsm::WADA); p.sc = (bf16*)(ws + wsm::SC); p.ada = (float*)(ws + wsm::ADA); p.X = (float*)(ws + wsm::X); p.Y = (float*)(ws + wsm::Y);
    p.XN = (bf16*)(ws + wsm::XN); p.H = (bf16*)(ws + wsm::H); p.QKV = (bf16*)(ws + wsm::QKV); p.AOB = (bf16*)(ws + wsm::AOB); p.OB = (bf16*)(ws + wsm::OB);
    p.U = (float*)(ws + wsm::U); p.SIN = (float*)(ws + wsm::SIN); p.PS = (float*)(ws + wsm::PS); p.ORET = (float*)(ws + wsm::ORET); p.OG = (float*)(ws + wsm::OG); p.LSE = (float*)(ws + wsm::LSE);
#if MK_ONE_LAUNCH
    a.ph_lo = 0; a.ph_hi = NPH;
    hipLaunchKernelGGL(fwd, dim3(grid), dim3(NT), LDS_BYTES, stream, a);
#else
    for (int ph = 0; ph < NPH; ++ph) {
        const int s = ph >= PH_L0 ? (ph - PH_L0) % PH_PER_LAYER : -1, L = ph >= PH_L0 ? (ph - PH_L0) / PH_PER_LAYER : -1;
        if (L == 1 && (s == S_MC || s == S_MD)) continue;
        a.ph_lo = ph; a.ph_hi = ph + 1;
        hipLaunchKernelGGL(fwd, dim3(grid), dim3(NT), LDS_BYTES, stream, a);
    }
#endif
    const hipError_t le = hipPeekAtLastError();
    if (le != hipSuccess) fprintf(stderr, "kernel_launch: launch failed: %s\n", hipGetErrorName(le));
}

#endif
```

```cpp
#ifndef HOST_SIM
#include <hip/hip_runtime.h>
#include <cstdio>
#include <cstdint>
#define HD __host__ __device__ __forceinline__
#else
#include <cmath>
#include <cstdio>
#include <cstdint>
#include <cstring>
#define HD inline
#endif

#ifndef CFG_D
#define CFG_D 1024
#define CFG_FF 2816
#define CFG_BATCH 2
#define CFG_SEQ 8192
#define CFG_DB 128
#define CFG_DS 4
#define CFG_PAST 2048
#define CFG_RH 4
#define CFG_RDK 256
#define CFG_RDV 512
#define CFG_RC 256
#define CFG_AH 8
#define CFG_AD 64
#define CFG_W0 128
#define CFG_DIL0 1
#define CFG_W1 512
#define CFG_DIL1 4
#define CFG_W2 2048
#define CFG_DIL2 16
#endif
namespace cfg {
constexpr int D = CFG_D, FF = CFG_FF, NFF = 2 * CFG_FF, BATCH = CFG_BATCH, SEQ = CFG_SEQ, DB = CFG_DB, DS = CFG_DS, PAST = CFG_PAST;
constexpr int MP = BATCH * SEQ, MS = DB * DS, M = MP + MS, NSEQ = BATCH + DB;
constexpr int RH = CFG_RH, RDK = CFG_RDK, RDV = CFG_RDV, RC = CFG_RC, QKW = RH * RDK, VW = RH * RDV, NRET = 2 * QKW + 2 * VW;
constexpr int NSEG = SEQ / RC, NITEM = BATCH * RH * NSEG;
constexpr int AH = CFG_AH, AD = CFG_AD, AO = AH * AD, NG = 3, NATT = 3 * NG * AO;
constexpr int SCR = ((NSEQ + 255) / 256) * 256;
constexpr int ADA_LD = 18 * D;
constexpr float LN_EPS = 1e-5f;
constexpr float ALPHA = 1.41421356237309515f;
HD int win(int g) { return g == 0 ? CFG_W0 : (g == 1 ? CFG_W1 : CFG_W2); }
HD int dil(int g) { return g == 0 ? CFG_DIL0 : (g == 1 ? CFG_DIL1 : CFG_DIL2); }
HD int nback(int g) { return win(g) / dil(g); }
HD int lbuf(int g) { return win(g) < PAST ? win(g) : PAST; }
HD int keep(int g) { return win(g) < SEQ ? win(g) : SEQ; }
constexpr long O_YP = 0, O_YS = O_YP + (long)MP * D, O_SRP = O_YS + (long)MS * D, O_SRS = O_SRP + (long)BATCH * RH * RDK * RDV, O_KV0 = O_SRS + (long)DB * RH * RDK * RDV;
}

typedef unsigned short bf16;
HD unsigned f2bf_u(float f) { unsigned u = __builtin_bit_cast(unsigned, f); return (u + 0x7fffu + ((u >> 16) & 1u)) >> 16; }
HD bf16 f2bf(float f) { return (bf16)f2bf_u(f); }
HD float bf2f(bf16 h) { unsigned u = (unsigned)h << 16; return __builtin_bit_cast(float, u); }
HD float silu_f(float x) { return x / (1.0f + expf(-x)); }
HD float swiglu_f(float a, float b) { return silu_f(a) * b; }
HD int seq_of_row(int m) { return m < cfg::MP ? m / cfg::SEQ : cfg::BATCH + (m - cfg::MP) / cfg::DS; }
HD float ret_log_gamma(int h) { return log1pf(-exp2f(-5.0f - (float)h)); }
HD float ret_pow(int h, float n) { return expf(n * ret_log_gamma(h)); }
HD float alibi_slope(int g, int head) { return exp2f(-8.0f * (float)(g * cfg::AH + head + 1) / (float)(cfg::NG * cfg::AH)); }
HD int ffn_dst_of_src(int c) { const int half = c / cfg::FF, j = c % cfg::FF; return 256 * (j / 128) + 128 * half + (j % 128); }
HD int ffn_src_of_dst(int r) { const int p = r / 256, rr = r % 256, half = rr / 128; return half * cfg::FF + 128 * p + rr % 128; }

struct Ptrs {
    const float *x_prompt, *x_sample, *c_prompt, *c_sample, *state_ret, *cache0, *cache1, *cache2, *w_ada, *b_ada, *ln_g, *ln_b, *w_ffn_in, *w_ffn_out, *w_ret_in, *ret_gn_g, *ret_gn_b, *w_ret_out, *w_att_in, *w_att_out;
    float* out;
    unsigned* ctl;
    bf16 *wfi_t, *wfo_t, *wri_t, *wro_t, *wai_t, *wao_t, *wada_t;
    bf16 *sc;
    float *ada;
    float *X, *Y;
    bf16 *XN, *H, *QKV, *AOB, *OB;
    float *U, *SIN, *PS, *ORET, *OG, *LSE;
};

HD const float* cache_ptr(const Ptrs& p, int g) { const uintptr_t m0 = (uintptr_t)0 - (uintptr_t)(g == 0), m1 = (uintptr_t)0 - (uintptr_t)(g == 1), m2 = (uintptr_t)0 - (uintptr_t)(g == 2); return (const float*)(((uintptr_t)p.cache0 & m0) | ((uintptr_t)p.cache1 & m1) | ((uintptr_t)p.cache2 & m2)); }
HD void it_silu_c(const Ptrs& p, long i) {
    using namespace cfg; const int r = (int)(i / D), k = (int)(i % D); float v = 0.f;
    if (r < NSEQ) v = silu_f(r < BATCH ? p.c_prompt[(long)r * D + k] : p.c_sample[(long)(r - BATCH) * D + k]);
    p.sc[i] = f2bf(v);
}
HD const float* ada_vec(const Ptrs& p, int seq, int layer, int j, int which) { return p.ada + (size_t)seq * cfg::ADA_LD + layer * 9 * cfg::D + (j * 3 + which) * cfg::D; }
HD void it_mod0(const Ptrs& p, long i) {
    using namespace cfg; const int m = (int)(i / D), c = (int)(i % D);
    const float x = m < MP ? p.x_prompt[i] : p.x_sample[i - (long)MP * D];
    const int s = seq_of_row(m);
    p.X[i] = x; p.XN[i] = f2bf(x * (1.0f + ada_vec(p, s, 0, 0, 1)[c]) + ada_vec(p, s, 0, 0, 0)[c]);
}
HD void it_ln_row(const Ptrs& p, int m, int layer, int j, float coef, int nl, int nj) {
    using namespace cfg; const int s = seq_of_row(m); const float* gate = ada_vec(p, s, layer, j, 2);
    float* X = p.X + (size_t)m * D; const float* Y = p.Y + (size_t)m * D;
    const float* lg = p.ln_g + (size_t)(layer * 3 + j) * D; const float* lb = p.ln_b + (size_t)(layer * 3 + j) * D;
    float sum = 0.f; for (int c = 0; c < D; ++c) sum += ALPHA * X[c] + coef * (1.0f + gate[c]) * Y[c];
    const float mu = sum / (float)D; float sq = 0.f;
    for (int c = 0; c < D; ++c) { const float z = ALPHA * X[c] + coef * (1.0f + gate[c]) * Y[c] - mu; sq += z * z; }
    const float rstd = 1.0f / sqrtf(sq / (float)D + LN_EPS);
    if (nj >= 0) { const float* sh = ada_vec(p, s, nl, nj, 0); const float* sc = ada_vec(p, s, nl, nj, 1); bf16* XN = p.XN + (size_t)m * D;
        for (int c = 0; c < D; ++c) { const float z = ALPHA * X[c] + coef * (1.0f + gate[c]) * Y[c]; const float xn = (z - mu) * rstd * lg[c] + lb[c]; X[c] = xn; XN[c] = f2bf(xn * (1.0f + sc[c]) + sh[c]); } }
    else { float* o = p.out + (size_t)m * D;
        for (int c = 0; c < D; ++c) { const float z = ALPHA * X[c] + coef * (1.0f + gate[c]) * Y[c]; o[c] = (z - mu) * rstd * lg[c] + lb[c]; } }
}
HD void ret_item(int it, int& n, int& h, int& seg) { using namespace cfg; n = it / (RH * NSEG); h = (it / NSEG) % RH; seg = it % NSEG; }
HD void it_ret_local(const Ptrs& p, long i) {
    using namespace cfg; const int it = (int)(i / (RDK * RDV)), d = (int)(i / RDV) % RDK, e = (int)(i % RDV); int n, h, seg; ret_item(it, n, h, seg);
    const size_t m0 = (size_t)n * SEQ + (size_t)seg * RC; const float ks = 1.0f / sqrtf((float)RDK); float acc = 0.f;
    for (int s = 0; s < RC; ++s) { const bf16* row = p.QKV + (m0 + s) * NRET; acc += ret_pow(h, (float)(RC - 1 - s)) * ks * bf2f(row[QKW + h * RDK + d]) * bf2f(row[2 * QKW + h * RDV + e]); }
    p.U[i] = acc;
}
HD void it_ret_scan(const Ptrs& p, long i) {
    using namespace cfg; const int nh = (int)(i / (RDK * RDV)); const long de = i % (RDK * RDV); const int h = nh % RH; const float cd = ret_pow(h, (float)RC); float S = 0.f;
    for (int seg = 0; seg < NSEG; ++seg) { const size_t o = ((size_t)nh * NSEG + seg) * (RDK * RDV) + de; p.SIN[o] = S; S = cd * S + p.U[o]; }
    p.out[O_SRP + i] = S;
}
HD void it_ret_scores(const Ptrs& p, long i) {
    using namespace cfg; const int it = (int)(i / (RC * RC)), t = (int)(i / RC) % RC, s = (int)(i % RC); int n, h, seg; ret_item(it, n, h, seg);
    float v = 0.f;
    if (s <= t) { const size_t m0 = (size_t)n * SEQ + (size_t)seg * RC; const bf16* q = p.QKV + (m0 + t) * NRET + h * RDK; const bf16* k = p.QKV + (m0 + s) * NRET + QKW + h * RDK; float acc = 0.f;
        for (int d = 0; d < RDK; ++d) acc += bf2f(q[d]) * bf2f(k[d]);
        v = acc * (1.0f / sqrtf((float)RDK)) * ret_pow(h, (float)(t - s)); }
    p.PS[i] = v;
}
HD void it_ret_out(const Ptrs& p, long i) {
    using namespace cfg; const int it = (int)(i / (RC * RDV)), t = (int)(i / RDV) % RC, e = (int)(i % RDV); int n, h, seg; ret_item(it, n, h, seg);
    const size_t m0 = (size_t)n * SEQ + (size_t)seg * RC; const float* P = p.PS + ((size_t)it * RC + t) * RC; float acc = 0.f;
    for (int s = 0; s <= t; ++s) acc += P[s] * bf2f(p.QKV[(m0 + s) * NRET + 2 * QKW + h * RDV + e]);
    const bf16* q = p.QKV + (m0 + t) * NRET + h * RDK; const float* S = p.SIN + (size_t)it * (RDK * RDV) + e; float a2 = 0.f;
    for (int d = 0; d < RDK; ++d) a2 += bf2f(q[d]) * S[(size_t)d * RDV];
    p.ORET[(m0 + t) * VW + h * RDV + e] = acc + ret_pow(h, (float)(t + 1)) * a2;
}
HD void it_rets_state(const Ptrs& p, long i) {
    using namespace cfg; const int nh = (int)(i / (RDK * RDV)), n = nh / RH, h = nh % RH, d = (int)(i / RDV) % RDK, e = (int)(i % RDV);
    const float ks = 1.0f / sqrtf((float)RDK); float acc = ret_pow(h, (float)DS) * p.state_ret[i];
    for (int s = 0; s < DS; ++s) { const bf16* row = p.QKV + ((size_t)MP + (size_t)n * DS + s) * NRET; acc += ret_pow(h, (float)(DS - 1 - s)) * ks * bf2f(row[QKW + h * RDK + d]) * bf2f(row[2 * QKW + h * RDV + e]); }
    p.out[O_SRS + i] = acc;
}
HD void it_rets_out(const Ptrs& p, long i) {
    using namespace cfg; const int ms = (int)(i / (RH * RDV)), h = (int)(i / RDV) % RH, e = (int)(i % RDV), n = ms / DS, t = ms % DS;
    const size_t r0 = (size_t)MP + (size_t)n * DS; const bf16* q = p.QKV + (r0 + t) * NRET + h * RDK; const float ks = 1.0f / sqrtf((float)RDK); float acc = 0.f;
    for (int s = 0; s <= t; ++s) { const bf16* k = p.QKV + (r0 + s) * NRET + QKW + h * RDK; float qk = 0.f; for (int d = 0; d < RDK; ++d) qk += bf2f(q[d]) * bf2f(k[d]);
        acc += qk * ks * ret_pow(h, (float)(t - s)) * bf2f(p.QKV[(r0 + s) * NRET + 2 * QKW + h * RDV + e]); }
    const float* S = p.state_ret + ((size_t)n * RH + h) * (RDK * RDV) + e; float a2 = 0.f;
    for (int d = 0; d < RDK; ++d) a2 += bf2f(q[d]) * S[(size_t)d * RDV];
    p.ORET[(r0 + t) * VW + h * RDV + e] = acc + ret_pow(h, (float)(t + 1)) * a2;
}
HD void it_ret_gate(const Ptrs& p, long i) {
    using namespace cfg; const size_t m = (size_t)(i / RH); const int h = (int)(i % RH); const float* o = p.ORET + m * VW + h * RDV; float sum = 0.f;
    for (int e = 0; e < RDV; ++e) sum += o[e];
    const float mu = sum / (float)RDV; float sq = 0.f; for (int e = 0; e < RDV; ++e) { const float z = o[e] - mu; sq += z * z; }
    const float rstd = 1.0f / sqrtf(sq / (float)RDV + LN_EPS); const bf16* g = p.QKV + m * NRET + 2 * QKW + VW + h * RDV;
    for (int e = 0; e < RDV; ++e) p.AOB[m * VW + h * RDV + e] = f2bf(silu_f(bf2f(g[e])) * ((o[e] - mu) * rstd * p.ret_gn_g[h * RDV + e] + p.ret_gn_b[h * RDV + e]));
}
HD void it_att(const Ptrs& p, long i) {
    using namespace cfg; const int dc = (int)(i % (AD / 8)), head = (int)(i / (AD / 8)) % AH, g = (int)(i / (AD / 8 * AH)) % NG; const int m = (int)(i / (AD / 8 * AH * NG));
    const int dl = dil(g), nb = nback(g), lb = lbuf(g); const float slope = alibi_slope(g, head) * (float)dl, scale = 1.0f / sqrtf((float)AD);
    const bf16* q = p.QKV + (size_t)m * NATT + g * AO + head * AD;
    float mx = -INFINITY, l = 0.f, a0 = 0.f, a1 = 0.f, a2 = 0.f, a3 = 0.f, a4 = 0.f, a5 = 0.f, a6 = 0.f, a7 = 0.f;
    const bool prompt = m < MP; const int t = prompt ? m % SEQ : (m - MP) % DS; const int nsmp = prompt ? 0 : (m - MP) / DS;
    for (int j = 0; j <= nb; ++j) {
        const bf16* kb = nullptr; const float* kf = nullptr;
        if (prompt) { const int pos = t - j * dl; if (pos < 0) break; kb = p.QKV + (size_t)(m - j * dl) * NATT + 3 * AO + g * AO + head * AD; }
        else { const int idx = lb + t - j * dl; if (idx < 0) break;
            if (idx >= lb) kb = p.QKV + ((size_t)MP + (size_t)nsmp * DS + (idx - lb)) * NATT + 3 * AO + g * AO + head * AD;
            else kf = cache_ptr(p, g) + (((size_t)nsmp * lb + idx) * 2) * AO + head * AD; }
        float sc = 0.f, v0, v1, v2, v3, v4, v5, v6, v7;
        if (kb) { for (int d = 0; d < AD; ++d) sc += bf2f(q[d]) * bf2f(kb[d]); const bf16* vb = kb + 3 * AO + dc * 8;
            v0 = bf2f(vb[0]); v1 = bf2f(vb[1]); v2 = bf2f(vb[2]); v3 = bf2f(vb[3]); v4 = bf2f(vb[4]); v5 = bf2f(vb[5]); v6 = bf2f(vb[6]); v7 = bf2f(vb[7]); }
        else { for (int d = 0; d < AD; ++d) sc += bf2f(q[d]) * kf[d]; const float* vf = kf + AO + dc * 8;
            v0 = vf[0]; v1 = vf[1]; v2 = vf[2]; v3 = vf[3]; v4 = vf[4]; v5 = vf[5]; v6 = vf[6]; v7 = vf[7]; }
        sc = sc * scale - slope * (float)j;
        const float mn = sc > mx ? sc : mx, f = expf(mx - mn), pj = expf(sc - mn);
        l = l * f + pj; mx = mn;
        a0 = a0 * f + pj * v0; a1 = a1 * f + pj * v1; a2 = a2 * f + pj * v2; a3 = a3 * f + pj * v3; a4 = a4 * f + pj * v4; a5 = a5 * f + pj * v5; a6 = a6 * f + pj * v6; a7 = a7 * f + pj * v7;
    }
    float* o = p.OG + ((size_t)g * M + m) * AO + head * AD + dc * 8; const float rl = 1.0f / l;
    o[0] = a0 * rl; o[1] = a1 * rl; o[2] = a2 * rl; o[3] = a3 * rl; o[4] = a4 * rl; o[5] = a5 * rl; o[6] = a6 * rl; o[7] = a7 * rl;
    if (dc == 0) p.LSE[((size_t)g * M + m) * AH + head] = mx + logf(l);
}
HD void it_att_merge(const Ptrs& p, long i) {
    using namespace cfg; const size_t m = (size_t)(i / AO); const int c = (int)(i % AO), head = c / AD;
    const float l0 = p.LSE[((size_t)0 * M + m) * AH + head], l1 = p.LSE[((size_t)1 * M + m) * AH + head], l2 = p.LSE[((size_t)2 * M + m) * AH + head];
    const float mx = fmaxf(l0, fmaxf(l1, l2)), w0 = expf(l0 - mx), w1 = expf(l1 - mx), w2 = expf(l2 - mx);
    const float acc = w0 * p.OG[((size_t)0 * M + m) * AO + c] + w1 * p.OG[((size_t)1 * M + m) * AO + c] + w2 * p.OG[((size_t)2 * M + m) * AO + c];
    p.OB[i] = f2bf(acc / (w0 + w1 + w2));
}
HD void it_kv_out(const Ptrs& p, long i) {
    using namespace cfg; long r = i;
    for (int g = 0; g < NG; ++g) {
        const long np = (long)BATCH * keep(g) * 2 * AO, ns = (long)MS * 2 * AO;
        if (r < np) { const int c = (int)(r % AO), kv = (int)(r / AO) % 2, row = (int)(r / (2 * AO)) % keep(g), n = (int)(r / ((long)2 * AO * keep(g)));
            const size_t m = (size_t)n * SEQ + (SEQ - keep(g)) + row; p.out[O_KV0 + i] = bf2f(p.QKV[m * NATT + (1 + kv) * 3 * AO + g * AO + c]); return; }
        r -= np;
        if (r < ns) { const int c = (int)(r % AO), kv = (int)(r / AO) % 2; const size_t m = (size_t)MP + (size_t)(r / (2 * AO)); p.out[O_KV0 + i] = bf2f(p.QKV[m * NATT + (1 + kv) * 3 * AO + g * AO + c]); return; }
        r -= ns;
    }
}
HD long kv_out_total() { using namespace cfg; long t = 0; for (int g = 0; g < NG; ++g) t += (long)BATCH * keep(g) * 2 * AO + (long)MS * 2 * AO; return t; }

#ifndef HOST_SIM
namespace pg8 {
#define PG8_LAS __attribute__((address_space(3)))
typedef unsigned short bf16_t;
typedef short bf16x8 __attribute__((ext_vector_type(8)));
typedef float f32x4 __attribute__((ext_vector_type(4)));
typedef unsigned u32x4 __attribute__((ext_vector_type(4)));
constexpr int BM = 256, BK = 64, HALF = 128, HTB = HALF * BK * 2  , STAGE_BYTES = 8 * HTB, NXCD = 8, WGM = 8;

__host__ __device__ __forceinline__ int lds_byte(int r, int c) { const int st = (r >> 4) * 2 + (c >> 5), rr = r & 15, cc = c & 31, ob = rr * 64 + cc * 2; return st * 1024 + (ob ^ (((ob >> 9) & 1) << 5)); }
__host__ __device__ __forceinline__ void stage_rc(int b, int& R, int& C) { const int st = b / 1024, sb = b % 1024, swz = sb ^ (((sb >> 9) & 1) << 5); R = (st >> 1) * 16 + swz / 64; C = (st & 1) * 32 + (swz % 64) / 2; }
__host__ __device__ __forceinline__ int perm32(int rho) { const int n = rho >> 4, i = rho & 15; return 8 * (i >> 2) + 4 * n + (i & 3); }

struct Unit { int pm, pn; };
struct Gemm { const bf16_t* A; const bf16_t* Bt; int M, N, K; };

struct StaticOrder {
    int nM, nN, nwg, G, c;
    __host__ __device__ void init(int M, int N, int G_, int c_) { nM = M / BM; nN = N / BM; nwg = nM * nN; G = G_; c = c_; }
    __host__ __device__ bool next(int i, Unit& u) const {
        const long L = (long)i * G + c; if (L >= nwg) return false;
        int wgid = (int)L; { const int q = nwg / NXCD, r = nwg % NXCD, xcd = wgid % NXCD, off = wgid / NXCD; wgid = (xcd < r ? xcd * (q + 1) : r * (q + 1) + (xcd - r) * q) + off; }
        const int nig = WGM * nN, gid = wgid / nig, fm = gid * WGM, gsz = (nM - fm) < WGM ? (nM - fm) : WGM;
        u.pm = fm + ((wgid % nig) % gsz); u.pn = (wgid % nig) / gsz; return true;
    }
    __device__ __forceinline__ void a_ready(const Unit&) const {}
    __device__ __forceinline__ void done(const Unit&) const {}
};

__device__ __forceinline__ unsigned cvt_pk_bf16(float lo, float hi) { unsigned r; asm volatile("v_cvt_pk_bf16_f32 %0, %1, %2" : "=v"(r) : "v"(lo), "v"(hi)); return r; }
typedef float f32x2 __attribute__((ext_vector_type(2)));
__device__ __forceinline__ f32x2 gelu_pk(f32x2 v) {
    const f32x2 av = __builtin_elementwise_abs(v), d = av * 0.2316418882f + 1.0f;
    f32x2 t; t.x = __builtin_amdgcn_rcpf(d.x); t.y = __builtin_amdgcn_rcpf(d.y);
    f32x2 q = t * 0.5307027145f + (-0.7265760135f); q = q * t + 0.7107068705f; q = q * t + (-0.142248368f); q = q * t + 0.127414796f; q = q * t;
    const f32x2 s = (v * v) * (-0.72134752044f);
    f32x2 e; e.x = __builtin_amdgcn_exp2f(s.x); e.y = __builtin_amdgcn_exp2f(s.y);
    const f32x2 m = v * (q * e), r = v - m;
    f32x2 o; o.x = v.x < 0.f ? m.x : r.x; o.y = v.y < 0.f ? m.y : r.y; return o;
}

template <int ACT  > struct EpiBf16 {
    static constexpr bool PERM = true, AFTER_DRAIN = false; static_assert(ACT == 0 || ACT == 1, "EpiBf16: ACT is 0 (none) or 1 (gelu_pk)");
    bf16_t* O; int ldc; const float* bias; int split_cols; size_t split_stride; float scale0;
    __device__ __forceinline__ void operator()(const f32x4 (&acc)[2][2][4][2], const Unit& u, int wr, int wc, int fr, int fq) const {
        const int row0 = u.pm * BM + wr * 64 + fr; int colt = u.pn * BM; bf16_t* base = O;
        float sc = 1.f; if (split_cols) { const int t = colt / split_cols; base += (size_t)t * split_stride; colt -= t * split_cols; if (t == 0) sc = scale0; }
        const int col0 = colt + wc * 32 + 8 * fq, bcol0 = u.pn * BM + wc * 32 + 8 * fq;
        f32x4 bv[2][2];
#pragma unroll
        for (int bj = 0; bj < 2; ++bj)
#pragma unroll
            for (int n = 0; n < 2; ++n) bv[bj][n] = bias ? *(const f32x4*)(bias + bcol0 + bj * HALF + 4 * n) : (f32x4){0.f, 0.f, 0.f, 0.f};
#pragma unroll
        for (int ai = 0; ai < 2; ++ai)
#pragma unroll
            for (int m = 0; m < 4; ++m) { bf16_t* rowp = base + (size_t)(row0 + ai * HALF + m * 16) * ldc + col0;
#pragma unroll
                for (int bj = 0; bj < 2; ++bj) { f32x4 v0 = acc[ai][bj][m][0] + bv[bj][0], v1 = acc[ai][bj][m][1] + bv[bj][1];
                    if (ACT == 1) { f32x2 a = gelu_pk((f32x2){v0[0], v0[1]}), b = gelu_pk((f32x2){v0[2], v0[3]}), c = gelu_pk((f32x2){v1[0], v1[1]}), d = gelu_pk((f32x2){v1[2], v1[3]});
                        v0 = (f32x4){a.x, a.y, b.x, b.y}; v1 = (f32x4){c.x, c.y, d.x, d.y}; }
                    v0 = v0 * sc; v1 = v1 * sc; u32x4 w; w.x = cvt_pk_bf16(v0[0], v0[1]); w.y = cvt_pk_bf16(v0[2], v0[3]); w.z = cvt_pk_bf16(v1[0], v1[1]); w.w = cvt_pk_bf16(v1[2], v1[3]);
                    *(u32x4*)(rowp + bj * HALF) = w; } }
    }
};

struct EpiF32 {
    static constexpr bool PERM = false, AFTER_DRAIN = false;
    float* C; int ldc; const float* bias;
    __device__ __forceinline__ void operator()(const f32x4 (&acc)[2][2][4][2], const Unit& u, int wr, int wc, int fr, int fq) const {
        const int row0 = u.pm * BM + wr * 64 + fr, col0 = u.pn * BM + wc * 32 + 4 * fq;
        f32x4 bv[2][2];
#pragma unroll
        for (int bj = 0; bj < 2; ++bj)
#pragma unroll
            for (int n = 0; n < 2; ++n) bv[bj][n] = bias ? *(const f32x4*)(bias + col0 + bj * HALF + n * 16) : (f32x4){0.f, 0.f, 0.f, 0.f};
#pragma unroll
        for (int ai = 0; ai < 2; ++ai)
#pragma unroll
            for (int m = 0; m < 4; ++m) { float* rowp = C + (size_t)(row0 + ai * HALF + m * 16) * ldc + col0;
#pragma unroll
                for (int bj = 0; bj < 2; ++bj)
#pragma unroll
                    for (int n = 0; n < 2; ++n) *(f32x4*)(rowp + bj * HALF + n * 16) = acc[ai][bj][m][n] + bv[bj][n]; }
    }
};
struct EpiSwiglu {
    static constexpr bool PERM = true, AFTER_DRAIN = false;
    bf16_t* O; int ldc;
    __device__ __forceinline__ void operator()(const f32x4 (&acc)[2][2][4][2], const Unit& u, int wr, int wc, int fr, int fq) const {
        const int row0 = u.pm * BM + wr * 64 + fr, col0 = u.pn * HALF + wc * 32 + 8 * fq;
#pragma unroll
        for (int ai = 0; ai < 2; ++ai)
#pragma unroll
            for (int m = 0; m < 4; ++m) { bf16_t* rowp = O + (size_t)(row0 + ai * HALF + m * 16) * ldc + col0;
                const f32x4 a0 = acc[ai][0][m][0], a1 = acc[ai][0][m][1], b0 = acc[ai][1][m][0], b1 = acc[ai][1][m][1];
                u32x4 w; w.x = cvt_pk_bf16(swiglu_f(a0[0], b0[0]), swiglu_f(a0[1], b0[1])); w.y = cvt_pk_bf16(swiglu_f(a0[2], b0[2]), swiglu_f(a0[3], b0[3]));
                w.z = cvt_pk_bf16(swiglu_f(a1[0], b1[0]), swiglu_f(a1[1], b1[1])); w.w = cvt_pk_bf16(swiglu_f(a1[2], b1[2]), swiglu_f(a1[3], b1[3]));
                *(u32x4*)rowp = w; }
    }
};
template <class Epi, class Sched, bool ALIGN_EPI = false, bool SP2 = false>
__device__ __forceinline__ void gemm_phase(PG8_LAS unsigned char* lds, const Gemm g, const Sched& S, const Epi& E) {
    const int tid = threadIdx.x, wid = __builtin_amdgcn_readfirstlane(tid >> 6), lane = tid & 63, wr = wid >> 2, wc = wid & 3, fr = lane & 15, fq = lane >> 4;
    const int K = g.K, nt = K / BK;
    unsigned voffA[2], voffB[2];
#pragma unroll
    for (int i = 0; i < 2; ++i) { int R, C; stage_rc(tid * 16 + i * 8192, R, C); const int Rb = Epi::PERM ? ((R & ~31) + perm32(R & 31)) : R;
        voffA[i] = (unsigned)(R * K + C) * 2u; voffB[i] = (unsigned)(Rb * K + C) * 2u; }
    const size_t kstep = (size_t)(BK * 2);
    const size_t hstep = (size_t)HALF * K * 2;
    const size_t tstep = 2 * hstep;
    const unsigned ldsw = (unsigned)wid * 1024u;
    const int aoff = lds_byte(wr * 64 + fr, fq * 8), boff = lds_byte(wc * 32 + fr, fq * 8);
#define PG8_SA(b, h) (((b) * 2 + (h)) * HTB)
#define PG8_SB(b, h) ((4 + (b) * 2 + (h)) * HTB)
#define PG8_STAGE(bufoff, gbase, voff) do { _Pragma("unroll") for (int _i = 0; _i < 2; ++_i) \
        __builtin_amdgcn_global_load_lds((const unsigned*)((const char*)(gbase) + (voff)[_i]), (PG8_LAS unsigned*)(lds + (bufoff) + ldsw + _i * 8192), 16, 0, 0); } while (0)
#define PG8_LDA(dst, b, h) do { _Pragma("unroll") for (int m = 0; m < 4; ++m) _Pragma("unroll") for (int k = 0; k < 2; ++k) dst[m][k] = *(const PG8_LAS bf16x8*)(lds + PG8_SA(b, h) + aoff + m * 2048 + k * 1024); } while (0)
#define PG8_LDB(dst, b, h) do { _Pragma("unroll") for (int n = 0; n < 2; ++n) _Pragma("unroll") for (int k = 0; k < 2; ++k) dst[n][k] = *(const PG8_LAS bf16x8*)(lds + PG8_SB(b, h) + boff + n * 2048 + k * 1024); } while (0)
#define PG8_MMA(ai, bj, At, Bt) do { __builtin_amdgcn_s_setprio(1); _Pragma("unroll") for (int m = 0; m < 4; ++m) _Pragma("unroll") for (int n = 0; n < 2; ++n) _Pragma("unroll") for (int k = 0; k < 2; ++k) \
        acc[ai][bj][m][n] = __builtin_amdgcn_mfma_f32_16x16x32_bf16(Bt[n][k], At[m][k], acc[ai][bj][m][n], 0, 0, 0); __builtin_amdgcn_s_setprio(0); } while (0)
#define PG8_WAIT_V(n) asm volatile("s_waitcnt vmcnt(" #n ")" ::: "memory")
#define PG8_WAIT_L(n) asm volatile("s_waitcnt lgkmcnt(" #n ")" ::: "memory")
#define PG8_BAR __builtin_amdgcn_s_barrier()
#define PG8_SCHED __builtin_amdgcn_sched_barrier(0)
    Unit cur, nxt; int ui = 0;
    if (!S.next(0, cur)) return;
    f32x4 acc[2][2][4][2];
#pragma unroll
    for (int a = 0; a < 2; ++a)
#pragma unroll
        for (int b = 0; b < 2; ++b)
#pragma unroll
            for (int m = 0; m < 4; ++m)
#pragma unroll
                for (int n = 0; n < 2; ++n) acc[a][b][m][n] = (f32x4){0.f, 0.f, 0.f, 0.f};
    bf16x8 At[4][2], B0[2][2], B1[2][2];
    const char* cA = (const char*)g.A + (size_t)cur.pm * tstep; const char* cB = (const char*)g.Bt + (size_t)cur.pn * tstep;
    S.a_ready(cur);
    if constexpr (SP2) {
        PG8_STAGE(PG8_SB(0, 0), cB, voffB); PG8_STAGE(PG8_SB(0, 1), cB + hstep, voffB); PG8_STAGE(PG8_SA(0, 0), cA, voffA); PG8_STAGE(PG8_SA(0, 1), cA + hstep, voffA);
        if (wr == 1) PG8_BAR;
        PG8_WAIT_V(2); PG8_BAR;
        PG8_STAGE(PG8_SB(1, 0), cB + kstep, voffB); PG8_STAGE(PG8_SA(1, 0), cA + kstep, voffA); PG8_STAGE(PG8_SB(1, 1), cB + hstep + kstep, voffB);
        PG8_WAIT_V(6); PG8_BAR;
    } else {
        PG8_STAGE(PG8_SB(0, 0), cB, voffB); PG8_STAGE(PG8_SA(0, 0), cA, voffA); PG8_STAGE(PG8_SB(0, 1), cB + hstep, voffB); PG8_STAGE(PG8_SA(0, 1), cA + hstep, voffA);
        if (wr == 1) PG8_BAR;
        PG8_WAIT_V(4); PG8_BAR;
        PG8_STAGE(PG8_SB(1, 0), cB + kstep, voffB); PG8_STAGE(PG8_SA(1, 0), cA + kstep, voffA); PG8_STAGE(PG8_SB(1, 1), cB + hstep + kstep, voffB);
        PG8_WAIT_V(6); PG8_BAR;
    }
    for (;;) {
        const bool has_next = S.next(ui + 1, nxt);
        const char* nA = has_next ? (const char*)g.A + (size_t)nxt.pm * tstep : cA; const char* nB = has_next ? (const char*)g.Bt + (size_t)nxt.pn * tstep : cB;
        for (int t = 0; t < nt; t += 2) {
            const bool last = (t == nt - 2);
            const char* a1 = cA + (size_t)(t + 1) * kstep;
            const char* a2 = last ? nA : cA + (size_t)(t + 2) * kstep; const char* b2 = last ? nB : cB + (size_t)(t + 2) * kstep;
            const char* a3 = a2 + kstep; const char* b3 = b2 + kstep;
            if (last && has_next) S.a_ready(nxt);
            if constexpr (SP2) {
            PG8_LDB(B0, 0, 0); PG8_LDB(B1, 0, 1); PG8_SCHED; PG8_LDA(At, 0, 0); PG8_STAGE(PG8_SA(1, 1), a1 + hstep, voffA);
            PG8_WAIT_V(8); PG8_WAIT_L(0); PG8_BAR; PG8_MMA(0, 0, At, B0); PG8_MMA(0, 1, At, B1); PG8_BAR; PG8_SCHED;
            PG8_LDA(At, 0, 1); PG8_STAGE(PG8_SB(0, 0), b2, voffB); PG8_STAGE(PG8_SB(0, 1), b2 + hstep, voffB); PG8_STAGE(PG8_SA(0, 0), a2, voffA);
            PG8_WAIT_V(8); PG8_WAIT_L(0); PG8_BAR; PG8_MMA(1, 0, At, B0); PG8_MMA(1, 1, At, B1); PG8_BAR; PG8_SCHED;
            PG8_LDB(B0, 1, 0); PG8_LDB(B1, 1, 1); PG8_SCHED; PG8_LDA(At, 1, 0); PG8_STAGE(PG8_SA(0, 1), a2 + hstep, voffA);
            PG8_WAIT_V(8); PG8_WAIT_L(0); PG8_BAR; PG8_MMA(0, 0, At, B0); PG8_MMA(0, 1, At, B1); PG8_BAR; PG8_SCHED;
            PG8_LDA(At, 1, 1); PG8_STAGE(PG8_SB(1, 0), b3, voffB); PG8_STAGE(PG8_SB(1, 1), b3 + hstep, voffB); PG8_STAGE(PG8_SA(1, 0), a3, voffA);
            PG8_WAIT_V(8); PG8_WAIT_L(0); PG8_BAR; PG8_MMA(1, 0, At, B0); PG8_MMA(1, 1, At, B1); PG8_BAR; PG8_SCHED;
            } else {
            PG8_LDB(B0, 0, 0); PG8_SCHED; PG8_LDA(At, 0, 0); PG8_STAGE(PG8_SA(1, 1), a1 + hstep, voffA);
            PG8_WAIT_L(8); PG8_BAR; PG8_WAIT_L(0); PG8_MMA(0, 0, At, B0); PG8_BAR; PG8_SCHED;
            PG8_LDB(B1, 0, 1); PG8_STAGE(PG8_SB(0, 0), b2, voffB);
            PG8_BAR; PG8_WAIT_L(0); PG8_MMA(0, 1, At, B1); PG8_BAR;
            PG8_LDA(At, 0, 1); PG8_STAGE(PG8_SA(0, 0), a2, voffA);
            PG8_BAR; PG8_WAIT_L(0); PG8_MMA(1, 0, At, B0); PG8_BAR; PG8_SCHED;
            PG8_STAGE(PG8_SB(0, 1), b2 + hstep, voffB);
            PG8_WAIT_V(6); PG8_BAR; PG8_MMA(1, 1, At, B1); PG8_BAR;
            PG8_LDB(B0, 1, 0); PG8_SCHED; PG8_LDA(At, 1, 0); PG8_STAGE(PG8_SA(0, 1), a2 + hstep, voffA);
            PG8_WAIT_L(8); PG8_BAR; PG8_WAIT_L(0); PG8_MMA(0, 0, At, B0); PG8_BAR; PG8_SCHED;
            PG8_LDB(B1, 1, 1); PG8_STAGE(PG8_SB(1, 0), b3, voffB);
            PG8_BAR; PG8_WAIT_L(0); PG8_MMA(0, 1, At, B1); PG8_BAR;
            PG8_LDA(At, 1, 1); PG8_STAGE(PG8_SA(1, 0), a3, voffA);
            PG8_BAR; PG8_WAIT_L(0); PG8_MMA(1, 0, At, B0); PG8_BAR; PG8_SCHED;
            PG8_STAGE(PG8_SB(1, 1), b3 + hstep, voffB);
            PG8_WAIT_V(6); PG8_BAR; PG8_MMA(1, 1, At, B1); PG8_BAR;
            }
        }
        if constexpr (ALIGN_EPI) { if (wr == 0) PG8_BAR; }
        if constexpr (!Epi::AFTER_DRAIN) { E(acc, cur, wr, wc, fr, fq); S.done(cur); }
        if (!has_next) break;
#pragma unroll
        for (int a = 0; a < 2; ++a)
#pragma unroll
            for (int b = 0; b < 2; ++b)
#pragma unroll
                for (int m = 0; m < 4; ++m)
#pragma unroll
                    for (int n = 0; n < 2; ++n) acc[a][b][m][n] = (f32x4){0.f, 0.f, 0.f, 0.f};
        cur = nxt; cA = nA; cB = nB; ++ui;
        if constexpr (ALIGN_EPI) { if (wr == 1) PG8_BAR; }
    }
    PG8_WAIT_V(0);
    if constexpr (!ALIGN_EPI) { if (wr == 0) PG8_BAR; }
    PG8_BAR;
    if constexpr (Epi::AFTER_DRAIN) { E.fused(acc, cur, wr, wc, fr, fq, lds, wid, lane); S.done(cur); }
#undef PG8_SA
#undef PG8_SB
#undef PG8_STAGE
#undef PG8_LDA
#undef PG8_LDB
#undef PG8_MMA
#undef PG8_WAIT_V
#undef PG8_WAIT_L
#undef PG8_BAR
#undef PG8_SCHED
}
}

#define GAS __attribute__((address_space(1)))
#define LAS __attribute__((address_space(3)))
typedef unsigned v4u __attribute__((ext_vector_type(4)));
typedef float f32x4 __attribute__((ext_vector_type(4)));
typedef short bf16x8 __attribute__((ext_vector_type(8)));
typedef GAS unsigned gu32;
typedef GAS unsigned long long gu64;
#define RLX_AGENT __ATOMIC_RELAXED, __HIP_MEMORY_SCOPE_AGENT
#define LDS_WAIT() asm volatile("s_waitcnt lgkmcnt(0)" ::: "memory")
#define VM_WAIT() asm volatile("s_waitcnt vmcnt(0)" ::: "memory")
__device__ __forceinline__ unsigned long long rt() { return __builtin_amdgcn_s_memrealtime(); }
__device__ __forceinline__ unsigned pk2(float lo, float hi) { return f2bf_u(lo) | (f2bf_u(hi) << 16); }

#define XB_TMO      128
#define XB_XCNT(j)  (256  + 64 * (j))
#define XB_XSUB(j)  (1280 + 64 * (j))
#define XB_XGEN(j)  (2304 + 64 * (j))
#define XB_TOP      3328
#define XB_TOPGEN   3392
#define XCD_BAR_WORDS 3456
#define XB_SPIN_CAP (1u << 18)

__device__ __forceinline__ unsigned xb_ld(unsigned* p)              { return __hip_atomic_load(p, __ATOMIC_RELAXED, __HIP_MEMORY_SCOPE_AGENT); }
__device__ __forceinline__ unsigned xb_add(unsigned* p, unsigned v) { return __hip_atomic_fetch_add(p, v, __ATOMIC_RELAXED, __HIP_MEMORY_SCOPE_AGENT); }
__device__ __forceinline__ unsigned xb_xcc_id() { return (unsigned)__builtin_amdgcn_s_getreg((3 << 11) | 20) & 0xFu; }
#define XB_SPIN(cond, bar) do { unsigned _sp = 0; while (cond) { __builtin_amdgcn_s_sleep(1); \
    if ((++_sp & 255u) == 0u) { if (xb_ld(&(bar)[XB_TMO])) break; if (_sp > XB_SPIN_CAP) { atomicAdd(&(bar)[XB_TMO], 1u); break; } } } } while (0)

struct XcdBarrier {
    unsigned* bar; unsigned x;
    volatile LAS unsigned* st;
};

__device__ __forceinline__ XcdBarrier xcd_barrier_post(unsigned* bar, volatile LAS unsigned* st) {
    XcdBarrier b; b.bar = bar; b.x = xb_xcc_id(); b.st = st;
    if (threadIdx.x == 0) (void)xb_add(&bar[XB_XCNT(b.x)], 1u);
    return b;
}
__device__ __forceinline__ void xcd_barrier_complete(unsigned* bar, unsigned x, unsigned& nloc, unsigned& nx) {
    const unsigned G = gridDim.x * gridDim.y * gridDim.z;
    unsigned sum, cnt, mine, sp = 0u;
    for (;;) {
        sum = 0u; cnt = 0u; mine = 0u;
#pragma unroll
        for (unsigned j = 0; j < 16; ++j) { const unsigned c = xb_ld(&bar[XB_XCNT(j)]); sum += c; cnt += (c > 0u) ? 1u : 0u; mine = (j == x) ? c : mine; }
        if (sum == G) break;
        __builtin_amdgcn_s_sleep(1);
        if ((++sp & 255u) == 0u) { if (xb_ld(&bar[XB_TMO])) break; if (sp > XB_SPIN_CAP) { atomicAdd(&bar[XB_TMO], 1u); break; } }
    }
    nloc = mine > 0u ? mine : 1u; nx = cnt > 0u ? cnt : 1u;
}

__device__ __forceinline__ void xcd_barrier(const XcdBarrier& b) {
    asm volatile("s_waitcnt vmcnt(0)" ::: "memory");
    __syncthreads();
    if (threadIdx.x == 0) {
        unsigned* bar = b.bar;
        __builtin_amdgcn_s_waitcnt(0);
        unsigned nloc = b.st[0], nx = b.st[1];
        if (nloc == 0u) { xcd_barrier_complete(bar, b.x, nloc, nx); b.st[0] = nloc; b.st[1] = nx; }
        const unsigned old = xb_add(&bar[XB_XSUB(b.x)], 1u);
        const unsigned gen = old / nloc;
        if (old + 1u == (gen + 1u) * nloc) {
            __builtin_amdgcn_fence(__ATOMIC_RELEASE, "agent");
            asm volatile("s_waitcnt vmcnt(0)" ::: "memory");
            const unsigned og = xb_add(&bar[XB_TOP], 1u);
            const unsigned tg = og / nx;
            if (og + 1u == (tg + 1u) * nx) xb_add(&bar[XB_TOPGEN], 1u);
            else XB_SPIN(xb_ld(&bar[XB_TOPGEN]) == tg, bar);
            __builtin_amdgcn_fence(__ATOMIC_ACQUIRE, "agent");
            xb_add(&bar[XB_XGEN(b.x)], 1u);
            asm volatile("s_waitcnt vmcnt(0)" ::: "memory");
        } else {
            XB_SPIN(xb_ld(&bar[XB_XGEN(b.x)]) == gen, bar);
            __builtin_amdgcn_fence(__ATOMIC_ACQUIRE, "agent");
            asm volatile("s_waitcnt vmcnt(0)" ::: "memory");
        }
    }
    __syncthreads();
}

constexpr int NWAVES = 8, NT = NWAVES * 64;
#ifndef MK_ONE_LAUNCH
#define MK_ONE_LAUNCH 1
#endif
constexpr int PH_PRO = 0, PH_ADA = 1, PH_MOD0 = 2, PH_L0 = 3, PH_PER_LAYER = 13, NPH = PH_L0 + 2 * PH_PER_LAYER;
enum Slot { S_G1A = 0, S_G2A, S_LNA, S_MIN, S_MA, S_MB, S_MC, S_MD, S_MOUT, S_LNM, S_G1B, S_G2B, S_LNB };
namespace wsm {
using namespace cfg;
constexpr size_t al(size_t x) { return (x + 4095) & ~(size_t)4095; }
constexpr size_t CTL = 0, CTL_BYTES = 1u << 20;
constexpr size_t WFI = al(CTL + CTL_BYTES);
constexpr size_t WFO = al(WFI + (size_t)4 * NFF * D * 2);
constexpr size_t WRI = al(WFO + (size_t)4 * D * FF * 2);
constexpr size_t WRO = al(WRI + (size_t)NRET * D * 2);
constexpr size_t WAI = al(WRO + (size_t)D * VW * 2);
constexpr size_t WAO = al(WAI + (size_t)NATT * D * 2);
constexpr size_t WADA = al(WAO + (size_t)D * AO * 2);
constexpr size_t SC = al(WADA + (size_t)18 * D * D * 2);
constexpr size_t ADA = al(SC + (size_t)SCR * D * 2);
constexpr size_t X = al(ADA + (size_t)SCR * ADA_LD * 4);
constexpr size_t Y = al(X + (size_t)M * D * 4);
constexpr size_t XN = al(Y + (size_t)M * D * 4);
constexpr size_t H = al(XN + (size_t)M * D * 2);
constexpr size_t QKV = al(H + (size_t)M * FF * 2);
constexpr size_t AOB = al(QKV + (size_t)M * NRET * 2);
constexpr size_t OB = al(AOB + (size_t)M * VW * 2);
constexpr size_t U = al(OB + (size_t)M * AO * 2);
constexpr size_t SIN = al(U + (size_t)NITEM * RDK * RDV * 4);
constexpr size_t PS = al(SIN + (size_t)NITEM * RDK * RDV * 4);
constexpr size_t ORET = al(PS + (size_t)NITEM * RC * RC * 4);
constexpr size_t OG = al(ORET + (size_t)M * VW * 4);
constexpr size_t LSE = al(OG + (size_t)3 * M * AO * 4);
constexpr size_t END = al(LSE + (size_t)3 * M * AH * 4);
static_assert(NRET >= NATT, "QKV buffer is sized by the retention projection");
}
constexpr int CW_TMO = 0, CW_CODE = 1, CW_BAR = 4096;
constexpr int RING_OFF = 0, RING_BYTES = 131072;
constexpr int LDSCTL_OFF = RING_BYTES, MISC_OFF = LDSCTL_OFF + 320;
constexpr int LDS_BYTES = 147456;

struct Args { Ptrs p; int ph_lo, ph_hi; };

__device__ __forceinline__ const Args* kargs() { auto k = __builtin_amdgcn_kernarg_segment_ptr(); asm volatile("" : "+s"(k)); return (const Args*)k; }
#define GRID_ITEMS(total, call) do { const long _tot = (long)(total); for (long _i = (long)blockIdx.x * NT + threadIdx.x; _i < _tot; _i += (long)gridDim.x * NT) { call; } } while (0)

__device__ __forceinline__ void p0_transpose_item(const float* W, int K, int N, bf16* WT, int ffn, int row_off, LAS float* scr, int item, int lane) {
    const int nblk = N / 32, kb = item / nblk, nb = item % nblk, k0 = 64 * kb, n0 = 32 * nb;
    const int dst0 = ffn ? ffn_dst_of_src(n0) : row_off + n0;
#pragma unroll 8
    for (int i = 0; i < 32; ++i) { const int kk = 2 * i + (lane >> 5); scr[kk * 33 + (lane & 31)] = W[(size_t)(k0 + kk) * N + n0 + (lane & 31)]; }
    LDS_WAIT(); asm volatile("" ::: "memory");
    const int c = lane & 7;
#pragma unroll
    for (int j = 0; j < 4; ++j) { const int n = (lane >> 3) + 8 * j; const LAS float* s = scr + (8 * c) * 33 + n;
        v4u o; o.x = pk2(s[0 * 33], s[1 * 33]); o.y = pk2(s[2 * 33], s[3 * 33]); o.z = pk2(s[4 * 33], s[5 * 33]); o.w = pk2(s[6 * 33], s[7 * 33]);
        *(GAS v4u*)(WT + (size_t)(dst0 + n) * K + k0 + 8 * c) = o; }
    LDS_WAIT(); asm volatile("" ::: "memory");
}
__device__ __forceinline__ void p0_prologue(const Ptrs& p, LAS unsigned char* lds, int wave, int lane) {
    using namespace cfg;
    LAS float* scr = (LAS float*)(lds + RING_OFF + wave * 16384);
    const int gw = blockIdx.x * NWAVES + wave, NGW = gridDim.x * NWAVES;
    constexpr int I_FI = (D / 64) * (NFF / 32), I_FO = (FF / 64) * (D / 32), I_RI = (D / 64) * (NRET / 32), I_RO = (VW / 64) * (D / 32), I_AI = (D / 64) * (NATT / 32), I_AO = (AO / 64) * (D / 32), I_AD = (D / 64) * (9 * D / 32);
    constexpr int NITEMS = 4 * I_FI + 4 * I_FO + I_RI + I_RO + I_AI + I_AO + 2 * I_AD;
    for (int it = gw; it < NITEMS; it += NGW) {
        int r = it;
        if (r < 4 * I_FI) { const int w = r / I_FI; p0_transpose_item(p.w_ffn_in + (size_t)w * D * NFF, D, NFF, p.wfi_t + (size_t)w * NFF * D, 1, 0, scr, r % I_FI, lane); continue; } r -= 4 * I_FI;
        if (r < 4 * I_FO) { const int w = r / I_FO; p0_transpose_item(p.w_ffn_out + (size_t)w * FF * D, FF, D, p.wfo_t + (size_t)w * D * FF, 0, 0, scr, r % I_FO, lane); continue; } r -= 4 * I_FO;
        if (r < I_RI) { p0_transpose_item(p.w_ret_in, D, NRET, p.wri_t, 0, 0, scr, r, lane); continue; } r -= I_RI;
        if (r < I_RO) { p0_transpose_item(p.w_ret_out, VW, D, p.wro_t, 0, 0, scr, r, lane); continue; } r -= I_RO;
        if (r < I_AI) { p0_transpose_item(p.w_att_in, D, NATT, p.wai_t, 0, 0, scr, r, lane); continue; } r -= I_AI;
        if (r < I_AO) { p0_transpose_item(p.w_att_out, AO, D, p.wao_t, 0, 0, scr, r, lane); continue; } r -= I_AO;
        { const int w = r / I_AD; p0_transpose_item(p.w_ada + (size_t)w * D * 9 * D, D, 9 * D, p.wada_t, 0, w * 9 * D, scr, r % I_AD, lane); }
    }
    GRID_ITEMS((long)SCR * D, it_silu_c(p, _i));
}

__device__ __forceinline__ float wave_sum(float v) {
#pragma unroll
    for (int o = 1; o < 64; o <<= 1) v += __shfl_xor(v, o);
    return v;
}
__device__ __forceinline__ void ln_rows_phase(const Ptrs& p, int layer, int j, float coef, int nl, int nj, int wave, int lane) {
    using namespace cfg; static_assert(D == 1024, "ln_rows_phase: 64 lanes x 4 floats x 4");
    const int gw = blockIdx.x * NWAVES + wave, NGW = gridDim.x * NWAVES;
    const f32x4* lg = (const f32x4*)(p.ln_g + (size_t)(layer * 3 + j) * D) + lane; const f32x4* lb = (const f32x4*)(p.ln_b + (size_t)(layer * 3 + j) * D) + lane;
    f32x4 g4[4], b4[4];
#pragma unroll
    for (int jj = 0; jj < 4; ++jj) { g4[jj] = lg[64 * jj]; b4[jj] = lb[64 * jj]; }
    for (int m = gw; m < M; m += NGW) {
        const int s = seq_of_row(m);
        const f32x4* xr = (const f32x4*)(p.X + (size_t)m * D) + lane; const f32x4* yr = (const f32x4*)(p.Y + (size_t)m * D) + lane; const f32x4* gt = (const f32x4*)ada_vec(p, s, layer, j, 2) + lane;
        f32x4 z[4]; float sum = 0.f;
#pragma unroll
        for (int jj = 0; jj < 4; ++jj) { const f32x4 x = xr[64 * jj], y = yr[64 * jj], g = gt[64 * jj]; z[jj] = ALPHA * x + coef * (1.0f + g) * y; sum += (z[jj].x + z[jj].y) + (z[jj].z + z[jj].w); }
        const float mu = wave_sum(sum) * (1.0f / D); float sq = 0.f;
#pragma unroll
        for (int jj = 0; jj < 4; ++jj) { z[jj] = z[jj] - mu; sq += (z[jj].x * z[jj].x + z[jj].y * z[jj].y) + (z[jj].z * z[jj].z + z[jj].w * z[jj].w); }
        const float rstd = 1.0f / sqrtf(wave_sum(sq) * (1.0f / D) + LN_EPS);
        if (nj >= 0) {
            const f32x4* sh = (const f32x4*)ada_vec(p, s, nl, nj, 0) + lane; const f32x4* sc = (const f32x4*)ada_vec(p, s, nl, nj, 1) + lane;
            f32x4* xo = (f32x4*)(p.X + (size_t)m * D) + lane; unsigned long long* xn = (unsigned long long*)(p.XN + (size_t)m * D) + lane;
#pragma unroll
            for (int jj = 0; jj < 4; ++jj) { const f32x4 v = z[jj] * rstd * g4[jj] + b4[jj]; xo[64 * jj] = v; const f32x4 u = v * (1.0f + sc[64 * jj]) + sh[64 * jj];
                xn[64 * jj] = (unsigned long long)pk2(u.x, u.y) | ((unsigned long long)pk2(u.z, u.w) << 32); }
        } else {
            f32x4* o = (f32x4*)(p.out + (size_t)m * D) + lane;
#pragma unroll
            for (int jj = 0; jj < 4; ++jj) o[64 * jj] = z[jj] * rstd * g4[jj] + b4[jj];
        }
    }
}
__device__ __forceinline__ void ret_gate_phase(const Ptrs& p, const bf16* gbase, int gld, int wave, int lane) {
    using namespace cfg; static_assert(RDV == 512, "ret_gate_phase: 64 lanes x 8");
    const int gw = blockIdx.x * NWAVES + wave, NGW = gridDim.x * NWAVES;
    for (int it = gw; it < M * RH; it += NGW) {
        const size_t m = (size_t)(it / RH); const int h = it % RH;
        const f32x4* o = (const f32x4*)(p.ORET + m * VW + h * RDV) + 2 * lane; const f32x4 o0 = o[0], o1 = o[1];
        const v4u gq = *((const v4u*)(gbase + m * gld + h * RDV) + lane);
        const float mu = wave_sum((o0.x + o0.y) + (o0.z + o0.w) + (o1.x + o1.y) + (o1.z + o1.w)) * (1.0f / RDV);
        const f32x4 d0 = o0 - mu, d1 = o1 - mu;
        const float rstd = 1.0f / sqrtf(wave_sum((d0.x * d0.x + d0.y * d0.y) + (d0.z * d0.z + d0.w * d0.w) + (d1.x * d1.x + d1.y * d1.y) + (d1.z * d1.z + d1.w * d1.w)) * (1.0f / RDV) + LN_EPS);
        const f32x4* gg = (const f32x4*)(p.ret_gn_g + h * RDV) + 2 * lane; const f32x4* gb = (const f32x4*)(p.ret_gn_b + h * RDV) + 2 * lane;
        const f32x4 n0 = d0 * rstd * gg[0] + gb[0], n1 = d1 * rstd * gg[1] + gb[1];
        v4u w;
        w.x = pk2(silu_f(bf2f((bf16)(gq.x & 0xffffu))) * n0.x, silu_f(bf2f((bf16)(gq.x >> 16))) * n0.y); w.y = pk2(silu_f(bf2f((bf16)(gq.y & 0xffffu))) * n0.z, silu_f(bf2f((bf16)(gq.y >> 16))) * n0.w);
        w.z = pk2(silu_f(bf2f((bf16)(gq.z & 0xffffu))) * n1.x, silu_f(bf2f((bf16)(gq.z >> 16))) * n1.y); w.w = pk2(silu_f(bf2f((bf16)(gq.w & 0xffffu))) * n1.z, silu_f(bf2f((bf16)(gq.w >> 16))) * n1.w);
        *((v4u*)(p.AOB + m * VW + h * RDV) + lane) = w;
    }
}
__device__ __forceinline__ void rets_phase(const Ptrs& p, const bf16* qkv, int ld, LAS unsigned char* lds, int tid, int wave, int lane) {
    using namespace cfg; static_assert(DS == 4 && RDK == 256 && RDV == 512 && NT == 512, "rets_phase geometry");
    LAS float* qs = (LAS float*)lds;
    LAS float* kd = qs + 4 * RDK;
    LAS float* qk = kd + 4 * RDK;
    LAS float* op = qk + 16;
    const float ks = 1.0f / 16.0f;
    for (int it = blockIdx.x; it < DB * RH; it += gridDim.x) {
        const int n = it / RH, h = it % RH; const float lgam = ret_log_gamma(h);
        const bf16* rows = qkv + ((size_t)MP + (size_t)n * DS) * ld;
        __syncthreads();
        for (int i = tid; i < 4 * RDK; i += NT) { const int t = i >> 8, d = i & 255;
            qs[d * 4 + t] = bf2f(rows[(size_t)t * ld + h * RDK + d]) * expf((float)(t + 1) * lgam);
            kd[d * 4 + t] = bf2f(rows[(size_t)t * ld + QKW + h * RDK + d]) * ks * expf((float)(3 - t) * lgam); }
#pragma unroll
        for (int pi = 0; pi < 2; ++pi) { const int pr = 2 * wave + pi, t = pr >> 2, s = pr & 3; float a = 0.f;
#pragma unroll
            for (int c = 0; c < 4; ++c) { const int d = lane + 64 * c; a += bf2f(rows[(size_t)t * ld + h * RDK + d]) * bf2f(rows[(size_t)s * ld + QKW + h * RDK + d]); }
            a = wave_sum(a); if (lane == 0) qk[pr] = s <= t ? a * ks * expf((float)(t - s) * lgam) : 0.f; }
        const int ec = tid & 127, dr = tid >> 7;
        f32x4 vv[4];
#pragma unroll
        for (int s = 0; s < 4; ++s) { const unsigned long long w = *((const unsigned long long*)(rows + (size_t)s * ld + 2 * QKW + h * RDV) + ec);
            vv[s] = (f32x4){bf2f((bf16)(w & 0xffffu)), bf2f((bf16)((w >> 16) & 0xffffu)), bf2f((bf16)((w >> 32) & 0xffffu)), bf2f((bf16)(w >> 48))}; }
        LDS_WAIT(); __syncthreads();
        const float g4 = expf(4.0f * lgam);
        const f32x4* S0 = (const f32x4*)(p.state_ret + (size_t)it * (RDK * RDV)) + ec; f32x4* S1 = (f32x4*)(p.out + O_SRS + (size_t)it * (RDK * RDV)) + ec;
        f32x4 oa[4] = {(f32x4){0.f, 0.f, 0.f, 0.f}, (f32x4){0.f, 0.f, 0.f, 0.f}, (f32x4){0.f, 0.f, 0.f, 0.f}, (f32x4){0.f, 0.f, 0.f, 0.f}};
#pragma unroll 1
        for (int d0 = dr; d0 < RDK; d0 += 32) {
            f32x4 sv[8];
#pragma unroll
            for (int u = 0; u < 8; ++u) sv[u] = __builtin_nontemporal_load(S0 + (size_t)(d0 + 4 * u) * (RDV / 4));
#pragma unroll
            for (int u = 0; u < 8; ++u) { const int d = d0 + 4 * u;
                const f32x4 k4 = *(const LAS f32x4*)(kd + d * 4), q4 = *(const LAS f32x4*)(qs + d * 4);
                const f32x4 sn = g4 * sv[u] + k4.x * vv[0] + k4.y * vv[1] + k4.z * vv[2] + k4.w * vv[3];
                __builtin_nontemporal_store(sn, S1 + (size_t)d * (RDV / 4));
                oa[0] += q4.x * sv[u]; oa[1] += q4.y * sv[u]; oa[2] += q4.z * sv[u]; oa[3] += q4.w * sv[u]; }
        }
#pragma unroll
        for (int t = 0; t < 4; ++t) *((LAS f32x4*)(op + (dr * 4 + t) * RDV) + ec) = oa[t];
        LDS_WAIT(); __syncthreads();
        { const int t = tid >> 7;
            f32x4 o = *((LAS f32x4*)(op + (0 * 4 + t) * RDV) + ec) + *((LAS f32x4*)(op + (1 * 4 + t) * RDV) + ec) + *((LAS f32x4*)(op + (2 * 4 + t) * RDV) + ec) + *((LAS f32x4*)(op + (3 * 4 + t) * RDV) + ec);
#pragma unroll
            for (int s = 0; s < 4; ++s) o += qk[t * 4 + s] * vv[s];
            *((f32x4*)(p.ORET + ((size_t)MP + (size_t)n * DS + t) * VW + h * RDV) + ec) = o; }
    }
    __syncthreads();
}
#define IN(k) (lo <= (k) && (k) < hi)
#define SEAM(k) do { if (MK_ONE_LAUNCH && IN((k) + 1)) xcd_barrier(bar); } while (0)
template <int L> __device__ __forceinline__ void layer_phases(LAS unsigned char* lds, const XcdBarrier& bar, const int lo, const int hi, const int G) {
    using namespace cfg;
    const int tid = threadIdx.x, lane = tid & 63, wave = __builtin_amdgcn_readfirstlane(tid >> 6);
    constexpr int base = PH_L0 + PH_PER_LAYER * L;

        if (IN(base + S_G1A)) { const Ptrs p = kargs()->p;
            pg8::Gemm g{p.XN, p.wfi_t + (size_t)(L * 2 + 0) * NFF * D, M, NFF, D}; pg8::StaticOrder S; S.init(M, NFF, G, (int)blockIdx.x);
            pg8::EpiSwiglu E{p.H, FF};
            pg8::gemm_phase<pg8::EpiSwiglu, pg8::StaticOrder, true, true>(lds + RING_OFF, g, S, E);
            SEAM(base + S_G1A);
        }
        if (IN(base + S_G2A)) { const Ptrs p = kargs()->p;
            pg8::Gemm g{p.H, p.wfo_t + (size_t)(L * 2 + 0) * D * FF, M, D, FF}; pg8::StaticOrder S; S.init(M, D, G, (int)blockIdx.x);
            pg8::EpiF32 E{p.Y, D, nullptr};
            pg8::gemm_phase<pg8::EpiF32, pg8::StaticOrder, true, true>(lds + RING_OFF, g, S, E);
            SEAM(base + S_G2A);
        }
        if (IN(base + S_LNA)) { const Ptrs p = kargs()->p; ln_rows_phase(p, L, 0, 0.5f, L, 1, wave, lane); SEAM(base + S_LNA); }
        if constexpr (L == 0) {
            if (IN(base + S_MIN)) { const Ptrs p = kargs()->p;
                pg8::Gemm g{p.XN, p.wri_t, M, NRET, D}; pg8::StaticOrder S; S.init(M, NRET, G, (int)blockIdx.x);
                pg8::EpiBf16<0> E{p.QKV, NRET, nullptr, 0, 0, 1.f};
                pg8::gemm_phase<pg8::EpiBf16<0>, pg8::StaticOrder, true, true>(lds + RING_OFF, g, S, E);
                SEAM(base + S_MIN);
            }
            if (IN(base + S_MA)) { const Ptrs p = kargs()->p;
                GRID_ITEMS((long)NITEM * RDK * RDV, it_ret_local(p, _i));
                GRID_ITEMS((long)NITEM * RC * RC, it_ret_scores(p, _i));
                rets_phase(p, p.QKV, NRET, lds + RING_OFF, tid, wave, lane);
                SEAM(base + S_MA);
            }
            if (IN(base + S_MB)) { const Ptrs p = kargs()->p; GRID_ITEMS((long)BATCH * RH * RDK * RDV, it_ret_scan(p, _i)); SEAM(base + S_MB); }
            if (IN(base + S_MC)) { const Ptrs p = kargs()->p; GRID_ITEMS((long)NITEM * RC * RDV, it_ret_out(p, _i)); SEAM(base + S_MC); }
            if (IN(base + S_MD)) { const Ptrs p = kargs()->p; ret_gate_phase(p, p.QKV + 2 * QKW + VW, NRET, wave, lane); SEAM(base + S_MD); }
            if (IN(base + S_MOUT)) { const Ptrs p = kargs()->p;
                pg8::Gemm g{p.AOB, p.wro_t, M, D, VW}; pg8::StaticOrder S; S.init(M, D, G, (int)blockIdx.x);
                pg8::EpiF32 E{p.Y, D, nullptr};
                pg8::gemm_phase<pg8::EpiF32, pg8::StaticOrder, true, true>(lds + RING_OFF, g, S, E);
                SEAM(base + S_MOUT);
            }
        } else {
            if (IN(base + S_MIN)) { const Ptrs p = kargs()->p;
                pg8::Gemm g{p.XN, p.wai_t, M, NATT, D}; pg8::StaticOrder S; S.init(M, NATT, G, (int)blockIdx.x);
                pg8::EpiBf16<0> E{p.QKV, NATT, nullptr, 0, 0, 1.f};
                pg8::gemm_phase<pg8::EpiBf16<0>, pg8::StaticOrder, true, true>(lds + RING_OFF, g, S, E);
                SEAM(base + S_MIN);
            }
            if (IN(base + S_MA)) { const Ptrs p = kargs()->p;
                GRID_ITEMS((long)M * NG * AH * (AD / 8), it_att(p, _i));
                GRID_ITEMS(kv_out_total(), it_kv_out(p, _i));
                SEAM(base + S_MA);
            }
            if (IN(base + S_MB)) { const Ptrs p = kargs()->p; GRID_ITEMS((long)M * AO, it_att_merge(p, _i)); SEAM(base + S_MB + 2); }
            if (IN(base + S_MOUT)) { const Ptrs p = kargs()->p;
                pg8::Gemm g{p.OB, p.wao_t, M, D, AO}; pg8::StaticOrder S; S.init(M, D, G, (int)blockIdx.x);
                pg8::EpiF32 E{p.Y, D, nullptr};
                pg8::gemm_phase<pg8::EpiF32, pg8::StaticOrder, true, true>(lds + RING_OFF, g, S, E);
                SEAM(base + S_MOUT);
            }
        }
        if (IN(base + S_LNM)) { const Ptrs p = kargs()->p; ln_rows_phase(p, L, 1, 1.0f, L, 2, wave, lane); SEAM(base + S_LNM); }
        if (IN(base + S_G1B)) { const Ptrs p = kargs()->p;
            pg8::Gemm g{p.XN, p.wfi_t + (size_t)(L * 2 + 1) * NFF * D, M, NFF, D}; pg8::StaticOrder S; S.init(M, NFF, G, (int)blockIdx.x);
            pg8::EpiSwiglu E{p.H, FF};
            pg8::gemm_phase<pg8::EpiSwiglu, pg8::StaticOrder, true, true>(lds + RING_OFF, g, S, E);
            SEAM(base + S_G1B);
        }
        if (IN(base + S_G2B)) { const Ptrs p = kargs()->p;
            pg8::Gemm g{p.H, p.wfo_t + (size_t)(L * 2 + 1) * D * FF, M, D, FF}; pg8::StaticOrder S; S.init(M, D, G, (int)blockIdx.x);
            pg8::EpiF32 E{p.Y, D, nullptr};
            pg8::gemm_phase<pg8::EpiF32, pg8::StaticOrder, true, true>(lds + RING_OFF, g, S, E);
            SEAM(base + S_G2B);
        }
        if (IN(base + S_LNB)) { const Ptrs p = kargs()->p; ln_rows_phase(p, L, 2, 0.5f, L + 1, L == 0 ? 0 : -1, wave, lane); SEAM(base + S_LNB); }
    }
#undef IN
#undef SEAM
__global__ void __launch_bounds__(NT, 2) fwd(Args args) {
    using namespace cfg;
    extern __shared__ __attribute__((aligned(16))) unsigned char lds_raw[];
    LAS unsigned char* lds = (LAS unsigned char*)lds_raw;
    volatile LAS unsigned* MISC = (volatile LAS unsigned*)(lds + MISC_OFF);
    const int tid = threadIdx.x, lane = tid & 63, wave = __builtin_amdgcn_readfirstlane(tid >> 6);
    const int G = gridDim.x;
    for (int u = tid; u < (LDS_BYTES - LDSCTL_OFF) / 4; u += NT) ((LAS unsigned*)(lds + LDSCTL_OFF))[u] = 0u;
    __syncthreads();
    XcdBarrier bar; { unsigned* const ctl = kargs()->p.ctl; bar.bar = ctl + CW_BAR; bar.x = 0; bar.st = nullptr;
    if (MK_ONE_LAUNCH) bar = xcd_barrier_post(ctl + CW_BAR, MISC + 8); }
    const int lo = args.ph_lo, hi = args.ph_hi;
#define IN(k) (lo <= (k) && (k) < hi)
#define SEAM(k) do { if (MK_ONE_LAUNCH && IN((k) + 1)) xcd_barrier(bar); } while (0)

    if (IN(PH_PRO)) { const Ptrs p = kargs()->p; p0_prologue(p, lds, wave, lane); SEAM(PH_PRO); }
    if (IN(PH_ADA)) { const Ptrs p = kargs()->p;
        pg8::Gemm g{p.sc, p.wada_t, SCR, 18 * D, D}; pg8::StaticOrder S; S.init(SCR, 18 * D, G, (int)blockIdx.x);
        pg8::EpiF32 E{p.ada, ADA_LD, p.b_ada};
        pg8::gemm_phase<pg8::EpiF32, pg8::StaticOrder, true, true>(lds + RING_OFF, g, S, E);
        SEAM(PH_ADA);
    }
    if (IN(PH_MOD0)) { const Ptrs p = kargs()->p; GRID_ITEMS((long)M * D, it_mod0(p, _i)); SEAM(PH_MOD0); }

    layer_phases<0>(lds, bar, lo, hi, G);
    layer_phases<1>(lds, bar, lo, hi, G);
#undef IN
#undef SEAM
}

extern "C" void kernel_launch(void* const* d_in, const int* in_sizes, int n_in, void* d_out, int out_size, void* d_ws, size_t ws_size, hipStream_t stream) {
    using namespace cfg;
    static int grid = 0;
    if (grid == 0) {
        const long want_out = O_KV0 + kv_out_total();
        if (n_in != 20 || (long)out_size != want_out || ws_size < wsm::END) { fprintf(stderr, "kernel_launch: shape mismatch: n_in %d out %d (want %ld) ws %zu (want %zu); nothing launched\n", n_in, out_size, want_out, ws_size, (size_t)wsm::END); grid = -1; return; }
        int dev = 0, cus = 0, per_cu = 0;
        if (hipGetDevice(&dev) != hipSuccess || hipDeviceGetAttribute(&cus, hipDeviceAttributeMultiprocessorCount, dev) != hipSuccess) { grid = -1; return; }
        if (hipFuncSetAttribute((const void*)fwd, hipFuncAttributeMaxDynamicSharedMemorySize, LDS_BYTES) != hipSuccess) { fprintf(stderr, "kernel_launch: hipFuncSetAttribute failed\n"); grid = -1; return; }
        if (hipOccupancyMaxActiveBlocksPerMultiprocessor(&per_cu, (const void*)fwd, NT, LDS_BYTES) != hipSuccess || per_cu < 1) fprintf(stderr, "kernel_launch: note: occupancy query reports %d workgroups per CU\n", per_cu);
        (void)hipGetLastError();
        grid = cus;
    }
    if (grid < 0) return;
    unsigned char* ws = (unsigned char*)d_ws;
    if (hipMemsetAsync(ws + wsm::CTL, 0, wsm::CTL_BYTES, stream) != hipSuccess) return;
    Args a{};
    Ptrs& p = a.p; const float* const* in = (const float* const*)d_in;
    p.x_prompt = in[0]; p.x_sample = in[1]; p.c_prompt = in[2]; p.c_sample = in[3]; p.state_ret = in[4]; p.cache0 = in[5]; p.cache1 = in[6]; p.cache2 = in[7];
    p.w_ada = in[8]; p.b_ada = in[9]; p.ln_g = in[10]; p.ln_b = in[11]; p.w_ffn_in = in[12]; p.w_ffn_out = in[13]; p.w_ret_in = in[14]; p.ret_gn_g = in[15]; p.ret_gn_b = in[16];
    p.w_ret_out = in[17]; p.w_att_in = in[18]; p.w_att_out = in[19];
    p.out = (float*)d_out; p.ctl = (unsigned*)(ws + wsm::CTL);
    p.wfi_t = (bf16*)(ws + wsm::WFI); p.wfo_t = (bf16*)(ws + wsm::WFO); p.wri_t = (bf16*)(ws + wsm::WRI); p.wro_t = (bf16*)(ws + wsm::WRO); p.wai_t = (bf16*)(ws + wsm::WAI); p.wao_t = (bf16*)(ws + wsm::WAO);
    p.wada_t = (bf16*)(ws + wsm::WADA); p.sc = (bf16*)(ws + wsm::SC); p.ada = (float*)(ws + wsm::ADA); p.X = (float*)(ws + wsm::X); p.Y = (float*)(ws + wsm::Y);
    p.XN = (bf16*)(ws + wsm::XN); p.H = (bf16*)(ws + wsm::H); p.QKV = (bf16*)(ws + wsm::QKV); p.AOB = (bf16*)(ws + wsm::AOB); p.OB = (bf16*)(ws + wsm::OB);
    p.U = (float*)(ws + wsm::U); p.SIN = (float*)(ws + wsm::SIN); p.PS = (float*)(ws + wsm::PS); p.ORET = (float*)(ws + wsm::ORET); p.OG = (float*)(ws + wsm::OG); p.LSE = (float*)(ws + wsm::LSE);
#if MK_ONE_LAUNCH
    a.ph_lo = 0; a.ph_hi = NPH;
    hipLaunchKernelGGL(fwd, dim3(grid), dim3(NT), LDS_BYTES, stream, a);
#else
    for (int ph = 0; ph < NPH; ++ph) {
        const int s = ph >= PH_L0 ? (ph - PH_L0) % PH_PER_LAYER : -1, L = ph >= PH_L0 ? (ph - PH_L0) / PH_PER_LAYER : -1;
        if (L == 1 && (s == S_MC || s == S_MD)) continue;
        a.ph_lo = ph; a.ph_hi = ph + 1;
        hipLaunchKernelGGL(fwd, dim3(grid), dim3(NT), LDS_BYTES, stream, a);
    }
#endif
    const hipError_t le = hipPeekAtLastError();
    if (le != hipSuccess) fprintf(stderr, "kernel_launch: launch failed: %s\n", hipGetErrorName(le));
}

#endif
```

```cpp
#ifndef HOST_SIM
#include <hip/hip_runtime.h>
#include <cstdio>
#include <cstdint>
#define HD __host__ __device__ __forceinline__
#else
#include <cmath>
#include <cstdio>
#include <cstdint>
#include <cstring>
#define HD inline
#endif

#ifndef CFG_D
#define CFG_D 1024
#define CFG_FF 2816
#define CFG_BATCH 2
#define CFG_SEQ 8192
#define CFG_DB 128
#define CFG_DS 4
#define CFG_PAST 2048
#define CFG_RH 4
#define CFG_RDK 256
#define CFG_RDV 512
#define CFG_RC 256
#define CFG_AH 8
#define CFG_AD 64
#define CFG_W0 128
#define CFG_DIL0 1
#define CFG_W1 512
#define CFG_DIL1 4
#define CFG_W2 2048
#define CFG_DIL2 16
#endif
namespace cfg {
constexpr int D = CFG_D, FF = CFG_FF, NFF = 2 * CFG_FF, BATCH = CFG_BATCH, SEQ = CFG_SEQ, DB = CFG_DB, DS = CFG_DS, PAST = CFG_PAST;
constexpr int MP = BATCH * SEQ, MS = DB * DS, M = MP + MS, NSEQ = BATCH + DB;
constexpr int RH = CFG_RH, RDK = CFG_RDK, RDV = CFG_RDV, RC = CFG_RC, QKW = RH * RDK, VW = RH * RDV, NRET = 2 * QKW + 2 * VW;
constexpr int NSEG = SEQ / RC, NITEM = BATCH * RH * NSEG;
constexpr int AH = CFG_AH, AD = CFG_AD, AO = AH * AD, NG = 3, NATT = 3 * NG * AO;
constexpr int SCR = ((NSEQ + 255) / 256) * 256;
constexpr int ADA_LD = 18 * D;
constexpr float LN_EPS = 1e-5f;
constexpr float ALPHA = 1.41421356237309515f;
HD int win(int g) { return g == 0 ? CFG_W0 : (g == 1 ? CFG_W1 : CFG_W2); }
HD int dil(int g) { return g == 0 ? CFG_DIL0 : (g == 1 ? CFG_DIL1 : CFG_DIL2); }
HD int nback(int g) { return win(g) / dil(g); }
HD int lbuf(int g) { return win(g) < PAST ? win(g) : PAST; }
HD int keep(int g) { return win(g) < SEQ ? win(g) : SEQ; }
constexpr long O_YP = 0, O_YS = O_YP + (long)MP * D, O_SRP = O_YS + (long)MS * D, O_SRS = O_SRP + (long)BATCH * RH * RDK * RDV, O_KV0 = O_SRS + (long)DB * RH * RDK * RDV;
}

typedef unsigned short bf16;
HD unsigned f2bf_u(float f) { unsigned u = __builtin_bit_cast(unsigned, f); return (u + 0x7fffu + ((u >> 16) & 1u)) >> 16; }
HD bf16 f2bf(float f) { return (bf16)f2bf_u(f); }
HD float bf2f(bf16 h) { unsigned u = (unsigned)h << 16; return __builtin_bit_cast(float, u); }
HD float silu_f(float x) { return x / (1.0f + expf(-x)); }
HD float swiglu_f(float a, float b) { return silu_f(a) * b; }
HD int seq_of_row(int m) { return m < cfg::MP ? m / cfg::SEQ : cfg::BATCH + (m - cfg::MP) / cfg::DS; }
HD float ret_log_gamma(int h) { return log1pf(-exp2f(-5.0f - (float)h)); }
HD float ret_pow(int h, float n) { return expf(n * ret_log_gamma(h)); }
HD float alibi_slope(int g, int head) { return exp2f(-8.0f * (float)(g * cfg::AH + head + 1) / (float)(cfg::NG * cfg::AH)); }
HD int ffn_dst_of_src(int c) { const int half = c / cfg::FF, j = c % cfg::FF; return 256 * (j / 128) + 128 * half + (j % 128); }
HD int ffn_src_of_dst(int r) { const int p = r / 256, rr = r % 256, half = rr / 128; return half * cfg::FF + 128 * p + rr % 128; }

struct Ptrs {
    const float *x_prompt, *x_sample, *c_prompt, *c_sample, *state_ret, *cache0, *cache1, *cache2, *w_ada, *b_ada, *ln_g, *ln_b, *w_ffn_in, *w_ffn_out, *w_ret_in, *ret_gn_g, *ret_gn_b, *w_ret_out, *w_att_in, *w_att_out;
    float* out;
    unsigned* ctl;
    bf16 *wfi_t, *wfo_t, *wri_t, *wro_t, *wai_t, *wao_t, *wada_t;
    bf16 *sc;
    float *ada;
    float *X, *Y;
    bf16 *XN, *H, *QKV, *AOB, *OB;
    float *U, *SIN, *PS, *ORET, *OG, *LSE;
    bf16 *A2, *B2, *KB, *KT, *GB, *QS; float* UT;
};

HD const float* cache_ptr(const Ptrs& p, int g) { const uintptr_t m0 = (uintptr_t)0 - (uintptr_t)(g == 0), m1 = (uintptr_t)0 - (uintptr_t)(g == 1), m2 = (uintptr_t)0 - (uintptr_t)(g == 2); return (const float*)(((uintptr_t)p.cache0 & m0) | ((uintptr_t)p.cache1 & m1) | ((uintptr_t)p.cache2 & m2)); }
HD void it_silu_c(const Ptrs& p, long i) {
    using namespace cfg; const int r = (int)(i / D), k = (int)(i % D); float v = 0.f;
    if (r < NSEQ) v = silu_f(r < BATCH ? p.c_prompt[(long)r * D + k] : p.c_sample[(long)(r - BATCH) * D + k]);
    p.sc[i] = f2bf(v);
}
HD const float* ada_vec(const Ptrs& p, int seq, int layer, int j, int which) { return p.ada + (size_t)seq * cfg::ADA_LD + layer * 9 * cfg::D + (j * 3 + which) * cfg::D; }
HD void it_mod0(const Ptrs& p, long i) {
    using namespace cfg; const int m = (int)(i / D), c = (int)(i % D);
    const float x = m < MP ? p.x_prompt[i] : p.x_sample[i - (long)MP * D];
    const int s = seq_of_row(m);
    p.X[i] = x; p.XN[i] = f2bf(x * (1.0f + ada_vec(p, s, 0, 0, 1)[c]) + ada_vec(p, s, 0, 0, 0)[c]);
}
HD void it_ln_row(const Ptrs& p, int m, int layer, int j, float coef, int nl, int nj) {
    using namespace cfg; const int s = seq_of_row(m); const float* gate = ada_vec(p, s, layer, j, 2);
    float* X = p.X + (size_t)m * D; const float* Y = p.Y + (size_t)m * D;
    const float* lg = p.ln_g + (size_t)(layer * 3 + j) * D; const float* lb = p.ln_b + (size_t)(layer * 3 + j) * D;
    float sum = 0.f; for (int c = 0; c < D; ++c) sum += ALPHA * X[c] + coef * (1.0f + gate[c]) * Y[c];
    const float mu = sum / (float)D; float sq = 0.f;
    for (int c = 0; c < D; ++c) { const float z = ALPHA * X[c] + coef * (1.0f + gate[c]) * Y[c] - mu; sq += z * z; }
    const float rstd = 1.0f / sqrtf(sq / (float)D + LN_EPS);
    if (nj >= 0) { const float* sh = ada_vec(p, s, nl, nj, 0); const float* sc = ada_vec(p, s, nl, nj, 1); bf16* XN = p.XN + (size_t)m * D;
        for (int c = 0; c < D; ++c) { const float z = ALPHA * X[c] + coef * (1.0f + gate[c]) * Y[c]; const float xn = (z - mu) * rstd * lg[c] + lb[c]; X[c] = xn; XN[c] = f2bf(xn * (1.0f + sc[c]) + sh[c]); } }
    else { float* o = p.out + (size_t)m * D;
        for (int c = 0; c < D; ++c) { const float z = ALPHA * X[c] + coef * (1.0f + gate[c]) * Y[c]; o[c] = (z - mu) * rstd * lg[c] + lb[c]; } }
}
HD void ret_item(int it, int& n, int& h, int& seg) { using namespace cfg; n = it / (RH * NSEG); h = (it / NSEG) % RH; seg = it % NSEG; }
HD void it_ret_local(const Ptrs& p, long i) {
    using namespace cfg; const int it = (int)(i / (RDK * RDV)), d = (int)(i / RDV) % RDK, e = (int)(i % RDV); int n, h, seg; ret_item(it, n, h, seg);
    const size_t m0 = (size_t)n * SEQ + (size_t)seg * RC; const float ks = 1.0f / sqrtf((float)RDK); float acc = 0.f;
    for (int s = 0; s < RC; ++s) { const bf16* row = p.QKV + (m0 + s) * NRET; acc += ret_pow(h, (float)(RC - 1 - s)) * ks * bf2f(row[QKW + h * RDK + d]) * bf2f(row[2 * QKW + h * RDV + e]); }
    p.U[i] = acc;
}
HD void it_ret_scan(const Ptrs& p, long i) {
    using namespace cfg; const int nh = (int)(i / (RDK * RDV)); const long de = i % (RDK * RDV); const int h = nh % RH; const float cd = ret_pow(h, (float)RC); float S = 0.f;
    for (int seg = 0; seg < NSEG; ++seg) { const size_t o = ((size_t)nh * NSEG + seg) * (RDK * RDV) + de; p.SIN[o] = S; S = cd * S + p.U[o]; }
    p.out[O_SRP + i] = S;
}
HD void it_ret_scores(const Ptrs& p, long i) {
    using namespace cfg; const int it = (int)(i / (RC * RC)), t = (int)(i / RC) % RC, s = (int)(i % RC); int n, h, seg; ret_item(it, n, h, seg);
    float v = 0.f;
    if (s <= t) { const size_t m0 = (size_t)n * SEQ + (size_t)seg * RC; const bf16* q = p.QKV + (m0 + t) * NRET + h * RDK; const bf16* k = p.QKV + (m0 + s) * NRET + QKW + h * RDK; float acc = 0.f;
        for (int d = 0; d < RDK; ++d) acc += bf2f(q[d]) * bf2f(k[d]);
        v = acc * (1.0f / sqrtf((float)RDK)) * ret_pow(h, (float)(t - s)); }
    p.PS[i] = v;
}
HD void it_ret_out(const Ptrs& p, long i) {
    using namespace cfg; const int it = (int)(i / (RC * RDV)), t = (int)(i / RDV) % RC, e = (int)(i % RDV); int n, h, seg; ret_item(it, n, h, seg);
    const size_t m0 = (size_t)n * SEQ + (size_t)seg * RC; const float* P = p.PS + ((size_t)it * RC + t) * RC; float acc = 0.f;
    for (int s = 0; s <= t; ++s) acc += P[s] * bf2f(p.QKV[(m0 + s) * NRET + 2 * QKW + h * RDV + e]);
    const bf16* q = p.QKV + (m0 + t) * NRET + h * RDK; const float* S = p.SIN + (size_t)it * (RDK * RDV) + e; float a2 = 0.f;
    for (int d = 0; d < RDK; ++d) a2 += bf2f(q[d]) * S[(size_t)d * RDV];
    p.ORET[(m0 + t) * VW + h * RDV + e] = acc + ret_pow(h, (float)(t + 1)) * a2;
}
HD void it_rets_state(const Ptrs& p, long i) {
    using namespace cfg; const int nh = (int)(i / (RDK * RDV)), n = nh / RH, h = nh % RH, d = (int)(i / RDV) % RDK, e = (int)(i % RDV);
    const float ks = 1.0f / sqrtf((float)RDK); float acc = ret_pow(h, (float)DS) * p.state_ret[i];
    for (int s = 0; s < DS; ++s) { const bf16* row = p.QKV + ((size_t)MP + (size_t)n * DS + s) * NRET; acc += ret_pow(h, (float)(DS - 1 - s)) * ks * bf2f(row[QKW + h * RDK + d]) * bf2f(row[2 * QKW + h * RDV + e]); }
    p.out[O_SRS + i] = acc;
}
HD void it_rets_out(const Ptrs& p, long i) {
    using namespace cfg; const int ms = (int)(i / (RH * RDV)), h = (int)(i / RDV) % RH, e = (int)(i % RDV), n = ms / DS, t = ms % DS;
    const size_t r0 = (size_t)MP + (size_t)n * DS; const bf16* q = p.QKV + (r0 + t) * NRET + h * RDK; const float ks = 1.0f / sqrtf((float)RDK); float acc = 0.f;
    for (int s = 0; s <= t; ++s) { const bf16* k = p.QKV + (r0 + s) * NRET + QKW + h * RDK; float qk = 0.f; for (int d = 0; d < RDK; ++d) qk += bf2f(q[d]) * bf2f(k[d]);
        acc += qk * ks * ret_pow(h, (float)(t - s)) * bf2f(p.QKV[(r0 + s) * NRET + 2 * QKW + h * RDV + e]); }
    const float* S = p.state_ret + ((size_t)n * RH + h) * (RDK * RDV) + e; float a2 = 0.f;
    for (int d = 0; d < RDK; ++d) a2 += bf2f(q[d]) * S[(size_t)d * RDV];
    p.ORET[(r0 + t) * VW + h * RDV + e] = acc + ret_pow(h, (float)(t + 1)) * a2;
}
HD void it_ret_gate(const Ptrs& p, long i) {
    using namespace cfg; const size_t m = (size_t)(i / RH); const int h = (int)(i % RH); const float* o = p.ORET + m * VW + h * RDV; float sum = 0.f;
    for (int e = 0; e < RDV; ++e) sum += o[e];
    const float mu = sum / (float)RDV; float sq = 0.f; for (int e = 0; e < RDV; ++e) { const float z = o[e] - mu; sq += z * z; }
    const float rstd = 1.0f / sqrtf(sq / (float)RDV + LN_EPS); const bf16* g = p.QKV + m * NRET + 2 * QKW + VW + h * RDV;
    for (int e = 0; e < RDV; ++e) p.AOB[m * VW + h * RDV + e] = f2bf(silu_f(bf2f(g[e])) * ((o[e] - mu) * rstd * p.ret_gn_g[h * RDV + e] + p.ret_gn_b[h * RDV + e]));
}
HD void it_att(const Ptrs& p, long i) {
    using namespace cfg; const int dc = (int)(i % (AD / 8)), head = (int)(i / (AD / 8)) % AH, g = (int)(i / (AD / 8 * AH)) % NG; const int m = (int)(i / (AD / 8 * AH * NG));
    const int dl = dil(g), nb = nback(g), lb = lbuf(g); const float slope = alibi_slope(g, head) * (float)dl, scale = 1.0f / sqrtf((float)AD);
    const bf16* q = p.QKV + (size_t)m * NATT + g * AO + head * AD;
    float mx = -INFINITY, l = 0.f, a0 = 0.f, a1 = 0.f, a2 = 0.f, a3 = 0.f, a4 = 0.f, a5 = 0.f, a6 = 0.f, a7 = 0.f;
    const bool prompt = m < MP; const int t = prompt ? m % SEQ : (m - MP) % DS; const int nsmp = prompt ? 0 : (m - MP) / DS;
    for (int j = 0; j <= nb; ++j) {
        const bf16* kb = nullptr; const float* kf = nullptr;
        if (prompt) { const int pos = t - j * dl; if (pos < 0) break; kb = p.QKV + (size_t)(m - j * dl) * NATT + 3 * AO + g * AO + head * AD; }
        else { const int idx = lb + t - j * dl; if (idx < 0) break;
            if (idx >= lb) kb = p.QKV + ((size_t)MP + (size_t)nsmp * DS + (idx - lb)) * NATT + 3 * AO + g * AO + head * AD;
            else kf = cache_ptr(p, g) + (((size_t)nsmp * lb + idx) * 2) * AO + head * AD; }
        float sc = 0.f, v0, v1, v2, v3, v4, v5, v6, v7;
        if (kb) { for (int d = 0; d < AD; ++d) sc += bf2f(q[d]) * bf2f(kb[d]); const bf16* vb = kb + 3 * AO + dc * 8;
            v0 = bf2f(vb[0]); v1 = bf2f(vb[1]); v2 = bf2f(vb[2]); v3 = bf2f(vb[3]); v4 = bf2f(vb[4]); v5 = bf2f(vb[5]); v6 = bf2f(vb[6]); v7 = bf2f(vb[7]); }
        else { for (int d = 0; d < AD; ++d) sc += bf2f(q[d]) * kf[d]; const float* vf = kf + AO + dc * 8;
            v0 = vf[0]; v1 = vf[1]; v2 = vf[2]; v3 = vf[3]; v4 = vf[4]; v5 = vf[5]; v6 = vf[6]; v7 = vf[7]; }
        sc = sc * scale - slope * (float)j;
        const float mn = sc > mx ? sc : mx, f = expf(mx - mn), pj = expf(sc - mn);
        l = l * f + pj; mx = mn;
        a0 = a0 * f + pj * v0; a1 = a1 * f + pj * v1; a2 = a2 * f + pj * v2; a3 = a3 * f + pj * v3; a4 = a4 * f + pj * v4; a5 = a5 * f + pj * v5; a6 = a6 * f + pj * v6; a7 = a7 * f + pj * v7;
    }
    float* o = p.OG + ((size_t)g * M + m) * AO + head * AD + dc * 8; const float rl = 1.0f / l;
    o[0] = a0 * rl; o[1] = a1 * rl; o[2] = a2 * rl; o[3] = a3 * rl; o[4] = a4 * rl; o[5] = a5 * rl; o[6] = a6 * rl; o[7] = a7 * rl;
    if (dc == 0) p.LSE[((size_t)g * M + m) * AH + head] = mx + logf(l);
}
HD void it_att_merge(const Ptrs& p, long i) {
    using namespace cfg; const size_t m = (size_t)(i / AO); const int c = (int)(i % AO), head = c / AD;
    const float l0 = p.LSE[((size_t)0 * M + m) * AH + head], l1 = p.LSE[((size_t)1 * M + m) * AH + head], l2 = p.LSE[((size_t)2 * M + m) * AH + head];
    const float mx = fmaxf(l0, fmaxf(l1, l2)), w0 = expf(l0 - mx), w1 = expf(l1 - mx), w2 = expf(l2 - mx);
    const float acc = w0 * p.OG[((size_t)0 * M + m) * AO + c] + w1 * p.OG[((size_t)1 * M + m) * AO + c] + w2 * p.OG[((size_t)2 * M + m) * AO + c];
    p.OB[i] = f2bf(acc / (w0 + w1 + w2));
}
HD void it_kv_out(const Ptrs& p, long i) {
    using namespace cfg; long r = i;
    for (int g = 0; g < NG; ++g) {
        const long np = (long)BATCH * keep(g) * 2 * AO, ns = (long)MS * 2 * AO;
        if (r < np) { const int c = (int)(r % AO), kv = (int)(r / AO) % 2, row = (int)(r / (2 * AO)) % keep(g), n = (int)(r / ((long)2 * AO * keep(g)));
            const size_t m = (size_t)n * SEQ + (SEQ - keep(g)) + row; p.out[O_KV0 + i] = bf2f(p.QKV[m * NATT + (1 + kv) * 3 * AO + g * AO + c]); return; }
        r -= np;
        if (r < ns) { const int c = (int)(r % AO), kv = (int)(r / AO) % 2; const size_t m = (size_t)MP + (size_t)(r / (2 * AO)); p.out[O_KV0 + i] = bf2f(p.QKV[m * NATT + (1 + kv) * 3 * AO + g * AO + c]); return; }
        r -= ns;
    }
}
HD long kv_out_total() { using namespace cfg; long t = 0; for (int g = 0; g < NG; ++g) t += (long)BATCH * keep(g) * 2 * AO + (long)MS * 2 * AO; return t; }

#ifndef HOST_SIM
namespace pg8 {
#define PG8_LAS __attribute__((address_space(3)))
typedef unsigned short bf16_t;
typedef short bf16x8 __attribute__((ext_vector_type(8)));
typedef float f32x4 __attribute__((ext_vector_type(4)));
typedef unsigned u32x4 __attribute__((ext_vector_type(4)));
constexpr int BM = 256, BK = 64, HALF = 128, HTB = HALF * BK * 2  , STAGE_BYTES = 8 * HTB, NXCD = 8, WGM = 8;

__host__ __device__ __forceinline__ int lds_byte(int r, int c) { const int st = (r >> 4) * 2 + (c >> 5), rr = r & 15, cc = c & 31, ob = rr * 64 + cc * 2; return st * 1024 + (ob ^ (((ob >> 9) & 1) << 5)); }
__host__ __device__ __forceinline__ void stage_rc(int b, int& R, int& C) { const int st = b / 1024, sb = b % 1024, swz = sb ^ (((sb >> 9) & 1) << 5); R = (st >> 1) * 16 + swz / 64; C = (st & 1) * 32 + (swz % 64) / 2; }
__host__ __device__ __forceinline__ int perm32(int rho) { const int n = rho >> 4, i = rho & 15; return 8 * (i >> 2) + 4 * n + (i & 3); }

struct Unit { const char* a; const char* b; int pm, pn, ro, co, id; };
struct Gemm { int lda, ldb, K; };

struct StaticOrder {
    int nM, nN, nwg, G, c; const char* A; const char* Bt; size_t ta, tb;
    __host__ __device__ void init(const bf16_t* A_, int lda, const bf16_t* Bt_, int ldb, int M, int N, int G_, int c_) { nM = M / BM; nN = N / BM; nwg = nM * nN; G = G_; c = c_; A = (const char*)A_; Bt = (const char*)Bt_; ta = (size_t)BM * lda * 2; tb = (size_t)BM * ldb * 2; }
    __host__ __device__ bool next(int i, Unit& u) const {
        const long L = (long)i * G + c; if (L >= nwg) return false;
        int wgid = (int)L; { const int q = nwg / NXCD, r = nwg % NXCD, xcd = wgid % NXCD, off = wgid / NXCD; wgid = (xcd < r ? xcd * (q + 1) : r * (q + 1) + (xcd - r) * q) + off; }
        const int nig = WGM * nN, gid = wgid / nig, fm = gid * WGM, gsz = (nM - fm) < WGM ? (nM - fm) : WGM;
        u.pm = fm + ((wgid % nig) % gsz); u.pn = (wgid % nig) / gsz; u.a = A + (size_t)u.pm * ta; u.b = Bt + (size_t)u.pn * tb; u.ro = u.pm * BM; u.co = u.pn * BM; u.id = 0; return true;
    }
    __device__ __forceinline__ void a_ready(const Unit&) const {}
    __device__ __forceinline__ void done(const Unit&) const {}
};

__device__ __forceinline__ unsigned cvt_pk_bf16(float lo, float hi) { unsigned r; asm volatile("v_cvt_pk_bf16_f32 %0, %1, %2" : "=v"(r) : "v"(lo), "v"(hi)); return r; }
typedef float f32x2 __attribute__((ext_vector_type(2)));
__device__ __forceinline__ f32x2 gelu_pk(f32x2 v) {
    const f32x2 av = __builtin_elementwise_abs(v), d = av * 0.2316418882f + 1.0f;
    f32x2 t; t.x = __builtin_amdgcn_rcpf(d.x); t.y = __builtin_amdgcn_rcpf(d.y);
    f32x2 q = t * 0.5307027145f + (-0.7265760135f); q = q * t + 0.7107068705f; q = q * t + (-0.142248368f); q = q * t + 0.127414796f; q = q * t;
    const f32x2 s = (v * v) * (-0.72134752044f);
    f32x2 e; e.x = __builtin_amdgcn_exp2f(s.x); e.y = __builtin_amdgcn_exp2f(s.y);
    const f32x2 m = v * (q * e), r = v - m;
    f32x2 o; o.x = v.x < 0.f ? m.x : r.x; o.y = v.y < 0.f ? m.y : r.y; return o;
}

template <int ACT  > struct EpiBf16 {
    static constexpr bool PERM = true, AFTER_DRAIN = false; static_assert(ACT == 0 || ACT == 1, "EpiBf16: ACT is 0 (none) or 1 (gelu_pk)");
    bf16_t* O; int ldc; const float* bias; int split_cols; size_t split_stride; float scale0;
    __device__ __forceinline__ void operator()(const f32x4 (&acc)[2][2][4][2], const Unit& u, int wr, int wc, int fr, int fq) const {
        const int row0 = u.ro + wr * 64 + fr; int colt = u.co; bf16_t* base = O;
        float sc = 1.f; if (split_cols) { const int t = colt / split_cols; base += (size_t)t * split_stride; colt -= t * split_cols; if (t == 0) sc = scale0; }
        const int col0 = colt + wc * 32 + 8 * fq, bcol0 = u.co + wc * 32 + 8 * fq;
        f32x4 bv[2][2];
#pragma unroll
        for (int bj = 0; bj < 2; ++bj)
#pragma unroll
            for (int n = 0; n < 2; ++n) bv[bj][n] = bias ? *(const f32x4*)(bias + bcol0 + bj * HALF + 4 * n) : (f32x4){0.f, 0.f, 0.f, 0.f};
#pragma unroll
        for (int ai = 0; ai < 2; ++ai)
#pragma unroll
            for (int m = 0; m < 4; ++m) { bf16_t* rowp = base + (size_t)(row0 + ai * HALF + m * 16) * ldc + col0;
#pragma unroll
                for (int bj = 0; bj < 2; ++bj) { f32x4 v0 = acc[ai][bj][m][0] + bv[bj][0], v1 = acc[ai][bj][m][1] + bv[bj][1];
                    if (ACT == 1) { f32x2 a = gelu_pk((f32x2){v0[0], v0[1]}), b = gelu_pk((f32x2){v0[2], v0[3]}), c = gelu_pk((f32x2){v1[0], v1[1]}), d = gelu_pk((f32x2){v1[2], v1[3]});
                        v0 = (f32x4){a.x, a.y, b.x, b.y}; v1 = (f32x4){c.x, c.y, d.x, d.y}; }
                    v0 = v0 * sc; v1 = v1 * sc; u32x4 w; w.x = cvt_pk_bf16(v0[0], v0[1]); w.y = cvt_pk_bf16(v0[2], v0[3]); w.z = cvt_pk_bf16(v1[0], v1[1]); w.w = cvt_pk_bf16(v1[2], v1[3]);
                    *(u32x4*)(rowp + bj * HALF) = w; } }
    }
};

struct EpiF32 {
    static constexpr bool PERM = false, AFTER_DRAIN = false;
    float* C; int ldc; const float* bias;
    __device__ __forceinline__ void operator()(const f32x4 (&acc)[2][2][4][2], const Unit& u, int wr, int wc, int fr, int fq) const {
        const int row0 = u.ro + wr * 64 + fr, col0 = u.co + wc * 32 + 4 * fq;
        f32x4 bv[2][2];
#pragma unroll
        for (int bj = 0; bj < 2; ++bj)
#pragma unroll
            for (int n = 0; n < 2; ++n) bv[bj][n] = bias ? *(const f32x4*)(bias + col0 + bj * HALF + n * 16) : (f32x4){0.f, 0.f, 0.f, 0.f};
#pragma unroll
        for (int ai = 0; ai < 2; ++ai)
#pragma unroll
            for (int m = 0; m < 4; ++m) { float* rowp = C + (size_t)(row0 + ai * HALF + m * 16) * ldc + col0;
#pragma unroll
                for (int bj = 0; bj < 2; ++bj)
#pragma unroll
                    for (int n = 0; n < 2; ++n) *(f32x4*)(rowp + bj * HALF + n * 16) = acc[ai][bj][m][n] + bv[bj][n]; }
    }
};
struct EpiSwiglu {
    static constexpr bool PERM = true, AFTER_DRAIN = false;
    bf16_t* O; int ldc;
    __device__ __forceinline__ void operator()(const f32x4 (&acc)[2][2][4][2], const Unit& u, int wr, int wc, int fr, int fq) const {
        const int row0 = u.ro + wr * 64 + fr, col0 = (u.co >> 1) + wc * 32 + 8 * fq;
#pragma unroll
        for (int ai = 0; ai < 2; ++ai)
#pragma unroll
            for (int m = 0; m < 4; ++m) { bf16_t* rowp = O + (size_t)(row0 + ai * HALF + m * 16) * ldc + col0;
                const f32x4 a0 = acc[ai][0][m][0], a1 = acc[ai][0][m][1], b0 = acc[ai][1][m][0], b1 = acc[ai][1][m][1];
                u32x4 w; w.x = cvt_pk_bf16(swiglu_f(a0[0], b0[0]), swiglu_f(a0[1], b0[1])); w.y = cvt_pk_bf16(swiglu_f(a0[2], b0[2]), swiglu_f(a0[3], b0[3]));
                w.z = cvt_pk_bf16(swiglu_f(a1[0], b1[0]), swiglu_f(a1[1], b1[1])); w.w = cvt_pk_bf16(swiglu_f(a1[2], b1[2]), swiglu_f(a1[3], b1[3]));
                *(u32x4*)rowp = w; }
    }
};
struct RetBufs { bf16_t *A2, *B2, *KB, *KT, *GB, *QS; };
__device__ __forceinline__ float ret_l2g(int h) { return ret_log_gamma(h) * 1.44269504088896341f; }
struct OrdRetIn1 {
    int G, c; const char* A; const char* Bt;
    __device__ __forceinline__ bool next(int i, Unit& u) const {
        using namespace cfg; constexpr int NP = MP / 256, NPU = NP * 16, NSU = (MS / 256) * 24;
        const long L = (long)i * G + c; if (L >= NPU + NSU) return false;
        if (L < NPU) { u.pm = (int)L / 16; const int j = (int)L % 16; u.pn = j < 8 ? j : j + 8; } else { const int l = (int)L - NPU; u.pm = NP + l / 24; u.pn = l % 24; }
        u.a = A + (size_t)u.pm * (256 * D * 2); u.b = Bt + (size_t)u.pn * (256 * D * 2); u.ro = u.pm * 256; u.co = u.pn * 256; u.id = 0; return true;
    }
    __device__ __forceinline__ void a_ready(const Unit&) const {}
    __device__ __forceinline__ void done(const Unit&) const {}
};
struct EpiRetIn1 {
    static constexpr bool PERM = true, AFTER_DRAIN = false;
    RetBufs rb;
    __device__ __forceinline__ void operator()(const f32x4 (&acc)[2][2][4][2], const Unit& u, int wr, int wc, int fr, int fq) const {
        using namespace cfg; constexpr int NP = MP / 256;
        const int pm = u.pm, pn = u.pn, rl0 = wr * 64 + fr, cl0 = wc * 32 + 8 * fq;
        bf16_t* base; int ld; float l2g = 0.f, f0 = 1.f;
        if (pm < NP && pn < 8) { const int n = pm / NSEG, seg = pm % NSEG, h = pn & 3; const size_t it = ((size_t)n * RH + h) * NSEG + seg;
            if (pn < 4) { base = rb.A2 + it * (256 * 512) + 256; ld = 512; l2g = ret_l2g(h); }
            else { base = rb.KB + it * (256 * 256); ld = 256; l2g = -ret_l2g(h); f0 = 1.0f / 16.0f; } }
        else if (pn >= 16) { base = rb.GB + (size_t)pm * 256 * VW + (pn - 16) * 256; ld = VW; }
        else { base = rb.QS + (size_t)(pm - NP) * 256 * (2 * QKW + VW) + pn * 256; ld = 2 * QKW + VW; }
#pragma unroll
        for (int ai = 0; ai < 2; ++ai)
#pragma unroll
            for (int m = 0; m < 4; ++m) { const int tl = rl0 + ai * HALF + m * 16; const float f = f0 * exp2f(l2g * (float)(tl + 1)); bf16_t* rowp = base + (size_t)tl * ld + cl0;
#pragma unroll
                for (int bj = 0; bj < 2; ++bj) { const f32x4 v0 = acc[ai][bj][m][0] * f, v1 = acc[ai][bj][m][1] * f;
                    u32x4 w; w.x = cvt_pk_bf16(v0[0], v0[1]); w.y = cvt_pk_bf16(v0[2], v0[3]); w.z = cvt_pk_bf16(v1[0], v1[1]); w.w = cvt_pk_bf16(v1[2], v1[3]);
                    *(u32x4*)(rowp + bj * HALF) = w; } }
    }
};
struct OrdRetIn2 {
    int G, c; const char* A; const char* Bt;
    __device__ __forceinline__ bool next(int i, Unit& u) const {
        using namespace cfg; constexpr int NF = (QKW + VW) / 256, NU = NF * (MP / 256);
        const long L = (long)i * G + c; if (L >= NU) return false;
        u.pm = (int)L % NF; u.pn = (int)L / NF; u.a = A + (size_t)u.pm * (256 * D * 2); u.b = Bt + (size_t)u.pn * (256 * D * 2); u.ro = u.pm * 256; u.co = u.pn * 256; u.id = 0; return true;
    }
    __device__ __forceinline__ void a_ready(const Unit&) const {}
    __device__ __forceinline__ void done(const Unit&) const {}
};
struct EpiRetIn2 {
    static constexpr bool PERM = true, AFTER_DRAIN = false;
    RetBufs rb;
    __device__ __forceinline__ void operator()(const f32x4 (&acc)[2][2][4][2], const Unit& u, int wr, int wc, int fr, int fq) const {
        using namespace cfg;
        const int pm = u.pm, pn = u.pn, rl0 = wr * 64 + fr, cl0 = wc * 32 + 8 * fq, n = pn / NSEG, seg = pn % NSEG;
        bf16_t* base; int ld; float l2g = 0.f, f0 = 1.f;
        if (pm < 4) { const int h = pm; const size_t it = ((size_t)n * RH + h) * NSEG + seg; base = rb.KT + it * (256 * 256); ld = 256; l2g = -ret_l2g(h); f0 = 1.0f / 16.0f; }
        else { const int h = (pm - 4) >> 1, eh = (pm - 4) & 1; const size_t it = ((size_t)n * RH + h) * NSEG + seg; base = rb.B2 + (it * 512 + eh * 256) * 512; ld = 512; }
        float f[2][8];
#pragma unroll
        for (int bj = 0; bj < 2; ++bj)
#pragma unroll
            for (int j = 0; j < 8; ++j) f[bj][j] = f0 * exp2f(l2g * (float)(cl0 + bj * HALF + j + 1));
#pragma unroll
        for (int ai = 0; ai < 2; ++ai)
#pragma unroll
            for (int m = 0; m < 4; ++m) { bf16_t* rowp = base + (size_t)(rl0 + ai * HALF + m * 16) * ld + cl0;
#pragma unroll
                for (int bj = 0; bj < 2; ++bj) { const f32x4 v0 = acc[ai][bj][m][0], v1 = acc[ai][bj][m][1];
                    u32x4 w; w.x = cvt_pk_bf16(v0[0] * f[bj][0], v0[1] * f[bj][1]); w.y = cvt_pk_bf16(v0[2] * f[bj][2], v0[3] * f[bj][3]);
                    w.z = cvt_pk_bf16(v1[0] * f[bj][4], v1[1] * f[bj][5]); w.w = cvt_pk_bf16(v1[2] * f[bj][6], v1[3] * f[bj][7]);
                    *(u32x4*)(rowp + bj * HALF) = w; } }
    }
};
template <int NU, int PER, size_t SA, size_t PA, size_t SB, size_t PB, int RI, int RP, int CP> struct OrdBatch {
    int G, c; const char* A; const char* Bt;
    __device__ __forceinline__ bool next(int i, Unit& u) const {
        const int L = i * G + c; if (L >= NU) return false;
        const int it = L / PER, part = L % PER;
        u.a = A + (size_t)it * SA + (size_t)part * PA; u.b = Bt + (size_t)it * SB + (size_t)part * PB; u.pm = it; u.pn = part; u.ro = it * RI + part * RP; u.co = part * CP; u.id = it; return true;
    }
    __device__ __forceinline__ void a_ready(const Unit&) const {}
    __device__ __forceinline__ void done(const Unit&) const {}
};
struct OrdRetOut {
    int G, c; const char* A; const char* Bt;
    __device__ __forceinline__ bool next(int i, Unit& u) const {
        using namespace cfg; const long L = (long)i * G + c; if (L >= 2 * NITEM) return false;
        const int it = (int)L >> 1, part = (int)L & 1, n = it / (RH * NSEG), h = (it / NSEG) % RH, seg = it % NSEG;
        u.a = A + (size_t)it * (256 * 512 * 2); u.b = Bt + ((size_t)it * 512 + part * 256) * (512 * 2); u.pm = it; u.pn = part; u.ro = n * SEQ + seg * 256; u.co = h * RDV + part * 256; u.id = it; return true;
    }
    __device__ __forceinline__ void a_ready(const Unit&) const {}
    __device__ __forceinline__ void done(const Unit&) const {}
};
struct EpiMaskBf16 {
    static constexpr bool PERM = true, AFTER_DRAIN = false;
    bf16_t* O; int ldc;
    __device__ __forceinline__ void operator()(const f32x4 (&acc)[2][2][4][2], const Unit& u, int wr, int wc, int fr, int fq) const {
        int zz; asm volatile("v_mov_b32 %0, 0" : "=v"(zz));
        const int rl0 = wr * 64 + fr + zz, cl0 = wc * 32 + 8 * fq;
#pragma unroll
        for (int ai = 0; ai < 2; ++ai)
#pragma unroll
            for (int m = 0; m < 4; ++m) { const int t = rl0 + ai * HALF + m * 16; bf16_t* rowp = O + (size_t)(u.ro + t) * ldc + u.co + cl0;
#pragma unroll
                for (int bj = 0; bj < 2; ++bj) { const f32x4 v0 = acc[ai][bj][m][0], v1 = acc[ai][bj][m][1]; const int s0 = cl0 + bj * HALF;
                    u32x4 w; w.x = cvt_pk_bf16(s0 + 0 <= t ? v0[0] : 0.f, s0 + 1 <= t ? v0[1] : 0.f); w.y = cvt_pk_bf16(s0 + 2 <= t ? v0[2] : 0.f, s0 + 3 <= t ? v0[3] : 0.f);
                    w.z = cvt_pk_bf16(s0 + 4 <= t ? v1[0] : 0.f, s0 + 5 <= t ? v1[1] : 0.f); w.w = cvt_pk_bf16(s0 + 6 <= t ? v1[2] : 0.f, s0 + 7 <= t ? v1[3] : 0.f);
                    *(u32x4*)(rowp + bj * HALF) = w; } }
    }
};
template <class Epi, class Sched, bool ALIGN_EPI = false, bool SP2 = false>
__device__ __forceinline__ void gemm_phase(PG8_LAS unsigned char* lds, const Gemm g, const Sched& S, const Epi& E, const int wave_s) {
    int tid; asm volatile("v_mbcnt_lo_u32_b32 %0, -1, 0\n\tv_mbcnt_hi_u32_b32 %0, -1, %0" : "=v"(tid)); tid += wave_s * 64;
    const int wid = __builtin_amdgcn_readfirstlane(tid >> 6), lane = tid & 63, wr = wid >> 2, wc = wid & 3, fr = lane & 15, fq = lane >> 4;
    const int K = g.K, nt = K / BK;
    unsigned voffA[2], voffB[2];
#pragma unroll
    for (int i = 0; i < 2; ++i) { int R, C; stage_rc(tid * 16 + i * 8192, R, C); const int Rb = Epi::PERM ? ((R & ~31) + perm32(R & 31)) : R;
        voffA[i] = (unsigned)(R * g.lda + C) * 2u; voffB[i] = (unsigned)(Rb * g.ldb + C) * 2u; }
    const size_t kstep = (size_t)(BK * 2);
    const size_t hstepA = (size_t)HALF * g.lda * 2, hstepB = (size_t)HALF * g.ldb * 2;
    const unsigned ldsw = (unsigned)wid * 1024u;
    const int aoff = lds_byte(wr * 64 + fr, fq * 8), boff = lds_byte(wc * 32 + fr, fq * 8);
#define PG8_SA(b, h) (((b) * 2 + (h)) * HTB)
#define PG8_SB(b, h) ((4 + (b) * 2 + (h)) * HTB)
#define PG8_STAGE(bufoff, gbase, voff) do { _Pragma("unroll") for (int _i = 0; _i < 2; ++_i) \
        __builtin_amdgcn_global_load_lds((const unsigned*)((const char*)(gbase) + (voff)[_i]), (PG8_LAS unsigned*)(lds + (bufoff) + ldsw + _i * 8192), 16, 0, 0); } while (0)
#define PG8_LDA(dst, b, h) do { _Pragma("unroll") for (int m = 0; m < 4; ++m) _Pragma("unroll") for (int k = 0; k < 2; ++k) dst[m][k] = *(const PG8_LAS bf16x8*)(lds + PG8_SA(b, h) + aoff + m * 2048 + k * 1024); } while (0)
#define PG8_LDB(dst, b, h) do { _Pragma("unroll") for (int n = 0; n < 2; ++n) _Pragma("unroll") for (int k = 0; k < 2; ++k) dst[n][k] = *(const PG8_LAS bf16x8*)(lds + PG8_SB(b, h) + boff + n * 2048 + k * 1024); } while (0)
#define PG8_MMA(ai, bj, At, Bt) do { __builtin_amdgcn_s_setprio(1); _Pragma("unroll") for (int m = 0; m < 4; ++m) _Pragma("unroll") for (int n = 0; n < 2; ++n) _Pragma("unroll") for (int k = 0; k < 2; ++k) \
        acc[ai][bj][m][n] = __builtin_amdgcn_mfma_f32_16x16x32_bf16(Bt[n][k], At[m][k], acc[ai][bj][m][n], 0, 0, 0); __builtin_amdgcn_s_setprio(0); } while (0)
#define PG8_WAIT_V(n) asm volatile("s_waitcnt vmcnt(" #n ")" ::: "memory")
#define PG8_WAIT_L(n) asm volatile("s_waitcnt lgkmcnt(" #n ")" ::: "memory")
#define PG8_BAR __builtin_amdgcn_s_barrier()
#define PG8_SCHED __builtin_amdgcn_sched_barrier(0)
    Unit cur, nxt; int ui = 0;
    if (!S.next(0, cur)) return;
    f32x4 acc[2][2][4][2];
#pragma unroll
    for (int a = 0; a < 2; ++a)
#pragma unroll
        for (int b = 0; b < 2; ++b)
#pragma unroll
            for (int m = 0; m < 4; ++m)
#pragma unroll
                for (int n = 0; n < 2; ++n) acc[a][b][m][n] = (f32x4){0.f, 0.f, 0.f, 0.f};
    bf16x8 At[4][2], B0[2][2], B1[2][2];
    const char* cA = cur.a; const char* cB = cur.b;
    S.a_ready(cur);
    if constexpr (SP2) {
        PG8_STAGE(PG8_SB(0, 0), cB, voffB); PG8_STAGE(PG8_SB(0, 1), cB + hstepB, voffB); PG8_STAGE(PG8_SA(0, 0), cA, voffA); PG8_STAGE(PG8_SA(0, 1), cA + hstepA, voffA);
        if (wr == 1) PG8_BAR;
        PG8_WAIT_V(2); PG8_BAR;
        PG8_STAGE(PG8_SB(1, 0), cB + kstep, voffB); PG8_STAGE(PG8_SA(1, 0), cA + kstep, voffA); PG8_STAGE(PG8_SB(1, 1), cB + hstepB + kstep, voffB);
        PG8_WAIT_V(6); PG8_BAR;
    } else {
        PG8_STAGE(PG8_SB(0, 0), cB, voffB); PG8_STAGE(PG8_SA(0, 0), cA, voffA); PG8_STAGE(PG8_SB(0, 1), cB + hstepB, voffB); PG8_STAGE(PG8_SA(0, 1), cA + hstepA, voffA);
        if (wr == 1) PG8_BAR;
        PG8_WAIT_V(4); PG8_BAR;
        PG8_STAGE(PG8_SB(1, 0), cB + kstep, voffB); PG8_STAGE(PG8_SA(1, 0), cA + kstep, voffA); PG8_STAGE(PG8_SB(1, 1), cB + hstepB + kstep, voffB);
        PG8_WAIT_V(6); PG8_BAR;
    }
    for (;;) {
        const bool has_next = S.next(ui + 1, nxt);
        const char* nA = has_next ? nxt.a : cA; const char* nB = has_next ? nxt.b : cB;
        for (int t = 0; t < nt; t += 2) {
            const bool last = (t == nt - 2);
            const char* a1 = cA + (size_t)(t + 1) * kstep;
            const char* a2 = last ? nA : cA + (size_t)(t + 2) * kstep; const char* b2 = last ? nB : cB + (size_t)(t + 2) * kstep;
            const char* a3 = a2 + kstep; const char* b3 = b2 + kstep;
            if (last && has_next) S.a_ready(nxt);
            if constexpr (SP2) {
            PG8_LDB(B0, 0, 0); PG8_LDB(B1, 0, 1); PG8_SCHED; PG8_LDA(At, 0, 0); PG8_STAGE(PG8_SA(1, 1), a1 + hstepA, voffA);
            PG8_WAIT_V(8); PG8_WAIT_L(0); PG8_BAR; PG8_MMA(0, 0, At, B0); PG8_MMA(0, 1, At, B1); PG8_BAR; PG8_SCHED;
            PG8_LDA(At, 0, 1); PG8_STAGE(PG8_SB(0, 0), b2, voffB); PG8_STAGE(PG8_SB(0, 1), b2 + hstepB, voffB); PG8_STAGE(PG8_SA(0, 0), a2, voffA);
            PG8_WAIT_V(8); PG8_WAIT_L(0); PG8_BAR; PG8_MMA(1, 0, At, B0); PG8_MMA(1, 1, At, B1); PG8_BAR; PG8_SCHED;
            PG8_LDB(B0, 1, 0); PG8_LDB(B1, 1, 1); PG8_SCHED; PG8_LDA(At, 1, 0); PG8_STAGE(PG8_SA(0, 1), a2 + hstepA, voffA);
            PG8_WAIT_V(8); PG8_WAIT_L(0); PG8_BAR; PG8_MMA(0, 0, At, B0); PG8_MMA(0, 1, At, B1); PG8_BAR; PG8_SCHED;
            PG8_LDA(At, 1, 1); PG8_STAGE(PG8_SB(1, 0), b3, voffB); PG8_STAGE(PG8_SB(1, 1), b3 + hstepB, voffB); PG8_STAGE(PG8_SA(1, 0), a3, voffA);
            PG8_WAIT_V(8); PG8_WAIT_L(0); PG8_BAR; PG8_MMA(1, 0, At, B0); PG8_MMA(1, 1, At, B1); PG8_BAR; PG8_SCHED;
            } else {
            PG8_LDB(B0, 0, 0); PG8_SCHED; PG8_LDA(At, 0, 0); PG8_STAGE(PG8_SA(1, 1), a1 + hstepA, voffA);
            PG8_WAIT_L(8); PG8_BAR; PG8_WAIT_L(0); PG8_MMA(0, 0, At, B0); PG8_BAR; PG8_SCHED;
            PG8_LDB(B1, 0, 1); PG8_STAGE(PG8_SB(0, 0), b2, voffB);
            PG8_BAR; PG8_WAIT_L(0); PG8_MMA(0, 1, At, B1); PG8_BAR;
            PG8_LDA(At, 0, 1); PG8_STAGE(PG8_SA(0, 0), a2, voffA);
            PG8_BAR; PG8_WAIT_L(0); PG8_MMA(1, 0, At, B0); PG8_BAR; PG8_SCHED;
            PG8_STAGE(PG8_SB(0, 1), b2 + hstepB, voffB);
            PG8_WAIT_V(6); PG8_BAR; PG8_MMA(1, 1, At, B1); PG8_BAR;
            PG8_LDB(B0, 1, 0); PG8_SCHED; PG8_LDA(At, 1, 0); PG8_STAGE(PG8_SA(0, 1), a2 + hstepA, voffA);
            PG8_WAIT_L(8); PG8_BAR; PG8_WAIT_L(0); PG8_MMA(0, 0, At, B0); PG8_BAR; PG8_SCHED;
            PG8_LDB(B1, 1, 1); PG8_STAGE(PG8_SB(1, 0), b3, voffB);
            PG8_BAR; PG8_WAIT_L(0); PG8_MMA(0, 1, At, B1); PG8_BAR;
            PG8_LDA(At, 1, 1); PG8_STAGE(PG8_SA(1, 0), a3, voffA);
            PG8_BAR; PG8_WAIT_L(0); PG8_MMA(1, 0, At, B0); PG8_BAR; PG8_SCHED;
            PG8_STAGE(PG8_SB(1, 1), b3 + hstepB, voffB);
            PG8_WAIT_V(6); PG8_BAR; PG8_MMA(1, 1, At, B1); PG8_BAR;
            }
        }
        if constexpr (ALIGN_EPI) { if (wr == 0) PG8_BAR; }
        if constexpr (!Epi::AFTER_DRAIN) { int l2_; asm volatile("v_mbcnt_lo_u32_b32 %0, -1, 0\n\tv_mbcnt_hi_u32_b32 %0, -1, %0" : "=v"(l2_)); E(acc, cur, wr, wc, l2_ & 15, l2_ >> 4); S.done(cur); }
        if (!has_next) break;
#pragma unroll
        for (int a = 0; a < 2; ++a)
#pragma unroll
            for (int b = 0; b < 2; ++b)
#pragma unroll
                for (int m = 0; m < 4; ++m)
#pragma unroll
                    for (int n = 0; n < 2; ++n) acc[a][b][m][n] = (f32x4){0.f, 0.f, 0.f, 0.f};
        cur = nxt; cA = nA; cB = nB; ++ui;
        if constexpr (ALIGN_EPI) { if (wr == 1) PG8_BAR; }
    }
    PG8_WAIT_V(0);
    if constexpr (!ALIGN_EPI) { if (wr == 0) PG8_BAR; }
    PG8_BAR;
    if constexpr (Epi::AFTER_DRAIN) { E.fused(acc, cur, wr, wc, fr, fq, lds, wid, lane); S.done(cur); }
#undef PG8_SA
#undef PG8_SB
#undef PG8_STAGE
#undef PG8_LDA
#undef PG8_LDB
#undef PG8_MMA
#undef PG8_WAIT_V
#undef PG8_WAIT_L
#undef PG8_BAR
#undef PG8_SCHED
}
}

#define GAS __attribute__((address_space(1)))
#define LAS __attribute__((address_space(3)))
typedef unsigned v4u __attribute__((ext_vector_type(4)));
typedef float f32x4 __attribute__((ext_vector_type(4)));
typedef short bf16x8 __attribute__((ext_vector_type(8)));
typedef GAS unsigned gu32;
typedef GAS unsigned long long gu64;
#define RLX_AGENT __ATOMIC_RELAXED, __HIP_MEMORY_SCOPE_AGENT
#define LDS_WAIT() asm volatile("s_waitcnt lgkmcnt(0)" ::: "memory")
#define VM_WAIT() asm volatile("s_waitcnt vmcnt(0)" ::: "memory")
__device__ __forceinline__ unsigned long long rt() { return __builtin_amdgcn_s_memrealtime(); }
__device__ __forceinline__ unsigned pk2(float lo, float hi) { return f2bf_u(lo) | (f2bf_u(hi) << 16); }

#define XB_TMO      128
#define XB_XCNT(j)  (256  + 64 * (j))
#define XB_XSUB(j)  (1280 + 64 * (j))
#define XB_XGEN(j)  (2304 + 64 * (j))
#define XB_TOP      3328
#define XB_TOPGEN   3392
#define XCD_BAR_WORDS 3456
#define XB_SPIN_CAP (1u << 18)

__device__ __forceinline__ unsigned xb_ld(unsigned* p)              { return __hip_atomic_load(p, __ATOMIC_RELAXED, __HIP_MEMORY_SCOPE_AGENT); }
__device__ __forceinline__ unsigned xb_add(unsigned* p, unsigned v) { return __hip_atomic_fetch_add(p, v, __ATOMIC_RELAXED, __HIP_MEMORY_SCOPE_AGENT); }
__device__ __forceinline__ unsigned xb_xcc_id() { return (unsigned)__builtin_amdgcn_s_getreg((3 << 11) | 20) & 0xFu; }
#define XB_SPIN(cond, bar) do { unsigned _sp = 0; while (cond) { __builtin_amdgcn_s_sleep(1); \
    if ((++_sp & 255u) == 0u) { if (xb_ld(&(bar)[XB_TMO])) break; if (_sp > XB_SPIN_CAP) { atomicAdd(&(bar)[XB_TMO], 1u); break; } } } } while (0)

__device__ __forceinline__ int lane_id() { int l; asm volatile("v_mbcnt_lo_u32_b32 %0, -1, 0\n\tv_mbcnt_hi_u32_b32 %0, -1, %0" : "=v"(l)); return l; }
#define TIDX(ws) ((ws) * 64 + lane_id())
struct XcdBarrier {
    unsigned* bar; unsigned x;
    volatile LAS unsigned* st;
};

__device__ __forceinline__ XcdBarrier xcd_barrier_post(unsigned* bar, volatile LAS unsigned* st, const int wave_s) {
    XcdBarrier b; b.bar = bar; b.x = xb_xcc_id(); b.st = st;
    if (TIDX(wave_s) == 0) (void)xb_add(&bar[XB_XCNT(b.x)], 1u);
    return b;
}
__device__ __forceinline__ void xcd_barrier_complete(unsigned* bar, unsigned x, unsigned& nloc, unsigned& nx) {
    const unsigned G = gridDim.x * gridDim.y * gridDim.z;
    unsigned sum, cnt, mine, sp = 0u;
    for (;;) {
        sum = 0u; cnt = 0u; mine = 0u;
#pragma unroll
        for (unsigned j = 0; j < 16; ++j) { const unsigned c = xb_ld(&bar[XB_XCNT(j)]); sum += c; cnt += (c > 0u) ? 1u : 0u; mine = (j == x) ? c : mine; }
        if (sum == G) break;
        __builtin_amdgcn_s_sleep(1);
        if ((++sp & 255u) == 0u) { if (xb_ld(&bar[XB_TMO])) break; if (sp > XB_SPIN_CAP) { atomicAdd(&bar[XB_TMO], 1u); break; } }
    }
    nloc = mine > 0u ? mine : 1u; nx = cnt > 0u ? cnt : 1u;
}

__device__ __forceinline__ void xcd_barrier(const XcdBarrier& b, const int wave_s) {
    asm volatile("s_waitcnt vmcnt(0)" ::: "memory");
    __syncthreads();
    if (TIDX(wave_s) == 0) {
        unsigned* bar = b.bar;
        __builtin_amdgcn_s_waitcnt(0);
        unsigned nloc = b.st[0], nx = b.st[1];
        if (nloc == 0u) { xcd_barrier_complete(bar, b.x, nloc, nx); b.st[0] = nloc; b.st[1] = nx; }
        const unsigned old = xb_add(&bar[XB_XSUB(b.x)], 1u);
        const unsigned gen = old / nloc;
        if (old + 1u == (gen + 1u) * nloc) {
            __builtin_amdgcn_fence(__ATOMIC_RELEASE, "agent");
            asm volatile("s_waitcnt vmcnt(0)" ::: "memory");
            const unsigned og = xb_add(&bar[XB_TOP], 1u);
            const unsigned tg = og / nx;
            if (og + 1u == (tg + 1u) * nx) xb_add(&bar[XB_TOPGEN], 1u);
            else XB_SPIN(xb_ld(&bar[XB_TOPGEN]) == tg, bar);
            __builtin_amdgcn_fence(__ATOMIC_ACQUIRE, "agent");
            xb_add(&bar[XB_XGEN(b.x)], 1u);
            asm volatile("s_waitcnt vmcnt(0)" ::: "memory");
        } else {
            XB_SPIN(xb_ld(&bar[XB_XGEN(b.x)]) == gen, bar);
            __builtin_amdgcn_fence(__ATOMIC_ACQUIRE, "agent");
            asm volatile("s_waitcnt vmcnt(0)" ::: "memory");
        }
    }
    __syncthreads();
}

constexpr int NWAVES = 8, NT = NWAVES * 64;
#ifndef MK_ONE_LAUNCH
#define MK_ONE_LAUNCH 1
#endif
constexpr int PH_PRO = 0, PH_ADA = 1, PH_MOD0 = 2, PH_L0 = 3, PH_PER_LAYER = 13, NPH = PH_L0 + 2 * PH_PER_LAYER;
enum Slot { S_G1A = 0, S_G2A, S_LNA, S_MIN, S_MA, S_MB, S_MC, S_MD, S_MOUT, S_LNM, S_G1B, S_G2B, S_LNB };
namespace wsm {
using namespace cfg;
constexpr size_t al(size_t x) { return (x + 4095) & ~(size_t)4095; }
constexpr size_t CTL = 0, CTL_BYTES = 1u << 20;
constexpr size_t WFI = al(CTL + CTL_BYTES);
constexpr size_t WFO = al(WFI + (size_t)4 * NFF * D * 2);
constexpr size_t WRI = al(WFO + (size_t)4 * D * FF * 2);
constexpr size_t WRO = al(WRI + (size_t)NRET * D * 2);
constexpr size_t WAI = al(WRO + (size_t)D * VW * 2);
constexpr size_t WAO = al(WAI + (size_t)NATT * D * 2);
constexpr size_t WADA = al(WAO + (size_t)D * AO * 2);
constexpr size_t SC = al(WADA + (size_t)18 * D * D * 2);
constexpr size_t ADA = al(SC + (size_t)SCR * D * 2);
constexpr size_t X = al(ADA + (size_t)SCR * ADA_LD * 4);
constexpr size_t Y = al(X + (size_t)M * D * 4);
constexpr size_t XN = al(Y + (size_t)M * D * 4);
constexpr size_t H = al(XN + (size_t)M * D * 2);
constexpr size_t QKV = al(H + (size_t)M * FF * 2);
constexpr size_t AOB = al(QKV + (size_t)M * NRET * 2);
constexpr size_t OB = al(AOB + (size_t)M * VW * 2);
constexpr size_t U = al(OB + (size_t)M * AO * 2);
constexpr size_t SIN = al(U + (size_t)NITEM * RDK * RDV * 4);
constexpr size_t PS = al(SIN + (size_t)NITEM * RDK * RDV * 4);
constexpr size_t ORET = al(PS + (size_t)NITEM * RC * RC * 4);
constexpr size_t OG = al(ORET + (size_t)M * VW * 4);
constexpr size_t LSE = al(OG + (size_t)3 * M * AO * 4);
constexpr size_t A2 = al(LSE + (size_t)3 * M * AH * 4);
constexpr size_t B2 = al(A2 + (size_t)NITEM * 256 * 512 * 2);
constexpr size_t KB = al(B2 + (size_t)NITEM * 512 * 512 * 2);
constexpr size_t KT = al(KB + (size_t)NITEM * 256 * 256 * 2);
constexpr size_t UT = al(KT + (size_t)NITEM * 256 * 256 * 2);
constexpr size_t GB = al(UT + (size_t)NITEM * 512 * 256 * 4);
constexpr size_t QS = al(GB + (size_t)M * VW * 2);
constexpr size_t END = al(QS + (size_t)MS * (2 * QKW + VW) * 2);
static_assert(RC == 256 && RDK == 256 && RDV == 512 && SEQ % 256 == 0 && MS % 256 == 0, "MFMA retention geometry");
static_assert(NRET >= NATT, "QKV buffer is sized by the retention projection");
}
constexpr int CW_TMO = 0, CW_CODE = 1, CW_BAR = 4096;
constexpr int RING_OFF = 0, RING_BYTES = 131072;
constexpr int LDSCTL_OFF = RING_BYTES, MISC_OFF = LDSCTL_OFF + 320;
constexpr int LDS_BYTES = 147456;

struct Args { Ptrs p; int ph_lo, ph_hi; };

__device__ __forceinline__ const Args* kargs() { auto k = __builtin_amdgcn_kernarg_segment_ptr(); asm volatile("" : "+s"(k)); return (const Args*)k; }
#define GRID_ITEMS(total, call) do { const long _tot = (long)(total); for (long _i = (long)blockIdx.x * NT + tid; _i < _tot; _i += (long)gridDim.x * NT) { call; } } while (0)

__device__ __forceinline__ void p0_transpose_item(const float* W, int K, int N, bf16* WT, int ffn, int row_off, LAS float* scr, int item, int lane) {
    const int nblk = N / 32, kb = item / nblk, nb = item % nblk, k0 = 64 * kb, n0 = 32 * nb;
    const int dst0 = ffn ? ffn_dst_of_src(n0) : row_off + n0;
#pragma unroll 8
    for (int i = 0; i < 32; ++i) { const int kk = 2 * i + (lane >> 5); scr[kk * 33 + (lane & 31)] = W[(size_t)(k0 + kk) * N + n0 + (lane & 31)]; }
    LDS_WAIT(); asm volatile("" ::: "memory");
    const int c = lane & 7;
#pragma unroll
    for (int j = 0; j < 4; ++j) { const int n = (lane >> 3) + 8 * j; const LAS float* s = scr + (8 * c) * 33 + n;
        v4u o; o.x = pk2(s[0 * 33], s[1 * 33]); o.y = pk2(s[2 * 33], s[3 * 33]); o.z = pk2(s[4 * 33], s[5 * 33]); o.w = pk2(s[6 * 33], s[7 * 33]);
        *(GAS v4u*)(WT + (size_t)(dst0 + n) * K + k0 + 8 * c) = o; }
    LDS_WAIT(); asm volatile("" ::: "memory");
}
__device__ __forceinline__ void p0_prologue(const Ptrs& p, LAS unsigned char* lds, int tid, int wave, int lane) {
    using namespace cfg;
    LAS float* scr = (LAS float*)(lds + RING_OFF + wave * 16384);
    const int gw = blockIdx.x * NWAVES + wave, NGW = gridDim.x * NWAVES;
    constexpr int I_FI = (D / 64) * (NFF / 32), I_FO = (FF / 64) * (D / 32), I_RI = (D / 64) * (NRET / 32), I_RO = (VW / 64) * (D / 32), I_AI = (D / 64) * (NATT / 32), I_AO = (AO / 64) * (D / 32), I_AD = (D / 64) * (9 * D / 32);
    constexpr int NITEMS = 4 * I_FI + 4 * I_FO + I_RI + I_RO + I_AI + I_AO + 2 * I_AD;
    for (int it = gw; it < NITEMS; it += NGW) {
        int r = it;
        if (r < 4 * I_FI) { const int w = r / I_FI; p0_transpose_item(p.w_ffn_in + (size_t)w * D * NFF, D, NFF, p.wfi_t + (size_t)w * NFF * D, 1, 0, scr, r % I_FI, lane); continue; } r -= 4 * I_FI;
        if (r < 4 * I_FO) { const int w = r / I_FO; p0_transpose_item(p.w_ffn_out + (size_t)w * FF * D, FF, D, p.wfo_t + (size_t)w * D * FF, 0, 0, scr, r % I_FO, lane); continue; } r -= 4 * I_FO;
        if (r < I_RI) { p0_transpose_item(p.w_ret_in, D, NRET, p.wri_t, 0, 0, scr, r, lane); continue; } r -= I_RI;
        if (r < I_RO) { p0_transpose_item(p.w_ret_out, VW, D, p.wro_t, 0, 0, scr, r, lane); continue; } r -= I_RO;
        if (r < I_AI) { p0_transpose_item(p.w_att_in, D, NATT, p.wai_t, 0, 0, scr, r, lane); continue; } r -= I_AI;
        if (r < I_AO) { p0_transpose_item(p.w_att_out, AO, D, p.wao_t, 0, 0, scr, r, lane); continue; } r -= I_AO;
        { const int w = r / I_AD; p0_transpose_item(p.w_ada + (size_t)w * D * 9 * D, D, 9 * D, p.wada_t, 0, w * 9 * D, scr, r % I_AD, lane); }
    }
    GRID_ITEMS((long)SCR * D, it_silu_c(p, _i));
}

__device__ __forceinline__ float wave_sum(float v) {
#pragma unroll
    for (int o = 1; o < 64; o <<= 1) v += __shfl_xor(v, o);
    return v;
}
__device__ __forceinline__ void ln_rows_phase(const Ptrs& p, int layer, int j, float coef, int nl, int nj, int wave, int lane) {
    using namespace cfg; static_assert(D == 1024, "ln_rows_phase: 64 lanes x 4 floats x 4");
    const int gw = blockIdx.x * NWAVES + wave, NGW = gridDim.x * NWAVES;
    const f32x4* lg = (const f32x4*)(p.ln_g + (size_t)(layer * 3 + j) * D) + lane; const f32x4* lb = (const f32x4*)(p.ln_b + (size_t)(layer * 3 + j) * D) + lane;
    f32x4 g4[4], b4[4];
#pragma unroll
    for (int jj = 0; jj < 4; ++jj) { g4[jj] = lg[64 * jj]; b4[jj] = lb[64 * jj]; }
    for (int m = gw; m < M; m += NGW) {
        const int s = seq_of_row(m);
        const f32x4* xr = (const f32x4*)(p.X + (size_t)m * D) + lane; const f32x4* yr = (const f32x4*)(p.Y + (size_t)m * D) + lane; const f32x4* gt = (const f32x4*)ada_vec(p, s, layer, j, 2) + lane;
        f32x4 z[4]; float sum = 0.f;
#pragma unroll
        for (int jj = 0; jj < 4; ++jj) { const f32x4 x = xr[64 * jj], y = yr[64 * jj], g = gt[64 * jj]; z[jj] = ALPHA * x + coef * (1.0f + g) * y; sum += (z[jj].x + z[jj].y) + (z[jj].z + z[jj].w); }
        const float mu = wave_sum(sum) * (1.0f / D); float sq = 0.f;
#pragma unroll
        for (int jj = 0; jj < 4; ++jj) { z[jj] = z[jj] - mu; sq += (z[jj].x * z[jj].x + z[jj].y * z[jj].y) + (z[jj].z * z[jj].z + z[jj].w * z[jj].w); }
        const float rstd = 1.0f / sqrtf(wave_sum(sq) * (1.0f / D) + LN_EPS);
        if (nj >= 0) {
            const f32x4* sh = (const f32x4*)ada_vec(p, s, nl, nj, 0) + lane; const f32x4* sc = (const f32x4*)ada_vec(p, s, nl, nj, 1) + lane;
            f32x4* xo = (f32x4*)(p.X + (size_t)m * D) + lane; unsigned long long* xn = (unsigned long long*)(p.XN + (size_t)m * D) + lane;
#pragma unroll
            for (int jj = 0; jj < 4; ++jj) { const f32x4 v = z[jj] * rstd * g4[jj] + b4[jj]; xo[64 * jj] = v; const f32x4 u = v * (1.0f + sc[64 * jj]) + sh[64 * jj];
                xn[64 * jj] = (unsigned long long)pk2(u.x, u.y) | ((unsigned long long)pk2(u.z, u.w) << 32); }
        } else {
            f32x4* o = (f32x4*)(p.out + (size_t)m * D) + lane;
#pragma unroll
            for (int jj = 0; jj < 4; ++jj) o[64 * jj] = z[jj] * rstd * g4[jj] + b4[jj];
        }
    }
}
__device__ __forceinline__ void ret_gate_phase(const Ptrs& p, const bf16* gbase, int gld, int wave, int lane) {
    using namespace cfg; static_assert(RDV == 512, "ret_gate_phase: 64 lanes x 8");
    const int gw = blockIdx.x * NWAVES + wave, NGW = gridDim.x * NWAVES;
    for (int it = gw; it < M * RH; it += NGW) {
        const size_t m = (size_t)(it / RH); const int h = it % RH;
        const f32x4* o = (const f32x4*)(p.ORET + m * VW + h * RDV) + 2 * lane; const f32x4 o0 = o[0], o1 = o[1];
        const v4u gq = *((const v4u*)(gbase + m * gld + h * RDV) + lane);
        const float mu = wave_sum((o0.x + o0.y) + (o0.z + o0.w) + (o1.x + o1.y) + (o1.z + o1.w)) * (1.0f / RDV);
        const f32x4 d0 = o0 - mu, d1 = o1 - mu;
        const float rstd = 1.0f / sqrtf(wave_sum((d0.x * d0.x + d0.y * d0.y) + (d0.z * d0.z + d0.w * d0.w) + (d1.x * d1.x + d1.y * d1.y) + (d1.z * d1.z + d1.w * d1.w)) * (1.0f / RDV) + LN_EPS);
        const f32x4* gg = (const f32x4*)(p.ret_gn_g + h * RDV) + 2 * lane; const f32x4* gb = (const f32x4*)(p.ret_gn_b + h * RDV) + 2 * lane;
        const f32x4 n0 = d0 * rstd * gg[0] + gb[0], n1 = d1 * rstd * gg[1] + gb[1];
        v4u w;
        w.x = pk2(silu_f(bf2f((bf16)(gq.x & 0xffffu))) * n0.x, silu_f(bf2f((bf16)(gq.x >> 16))) * n0.y); w.y = pk2(silu_f(bf2f((bf16)(gq.y & 0xffffu))) * n0.z, silu_f(bf2f((bf16)(gq.y >> 16))) * n0.w);
        w.z = pk2(silu_f(bf2f((bf16)(gq.z & 0xffffu))) * n1.x, silu_f(bf2f((bf16)(gq.z >> 16))) * n1.y); w.w = pk2(silu_f(bf2f((bf16)(gq.w & 0xffffu))) * n1.z, silu_f(bf2f((bf16)(gq.w >> 16))) * n1.w);
        *((v4u*)(p.AOB + m * VW + h * RDV) + lane) = w;
    }
}
__device__ __forceinline__ void rets_phase(const Ptrs& p, const bf16* qkv, int ld, LAS unsigned char* lds, int tid, int wave, int lane) {
    using namespace cfg; static_assert(DS == 4 && RDK == 256 && RDV == 512 && NT == 512, "rets_phase geometry");
    LAS float* qs = (LAS float*)lds;
    LAS float* kd = qs + 4 * RDK;
    LAS float* qk = kd + 4 * RDK;
    LAS float* op = qk + 16;
    const float ks = 1.0f / 16.0f;
    for (int it = blockIdx.x; it < DB * RH; it += gridDim.x) {
        const int n = it / RH, h = it % RH; const float lgam = ret_log_gamma(h);
        const bf16* rows = qkv + ((size_t)MP + (size_t)n * DS) * ld;
        __syncthreads();
        for (int i = tid; i < 4 * RDK; i += NT) { const int t = i >> 8, d = i & 255;
            qs[d * 4 + t] = bf2f(rows[(size_t)t * ld + h * RDK + d]) * expf((float)(t + 1) * lgam);
            kd[d * 4 + t] = bf2f(rows[(size_t)t * ld + QKW + h * RDK + d]) * ks * expf((float)(3 - t) * lgam); }
#pragma unroll
        for (int pi = 0; pi < 2; ++pi) { const int pr = 2 * wave + pi, t = pr >> 2, s = pr & 3; float a = 0.f;
#pragma unroll
            for (int c = 0; c < 4; ++c) { const int d = lane + 64 * c; a += bf2f(rows[(size_t)t * ld + h * RDK + d]) * bf2f(rows[(size_t)s * ld + QKW + h * RDK + d]); }
            a = wave_sum(a); if (lane == 0) qk[pr] = s <= t ? a * ks * expf((float)(t - s) * lgam) : 0.f; }
        const int ec = tid & 127, dr = tid >> 7;
        f32x4 vv[4];
#pragma unroll
        for (int s = 0; s < 4; ++s) { const unsigned long long w = *((const unsigned long long*)(rows + (size_t)s * ld + 2 * QKW + h * RDV) + ec);
            vv[s] = (f32x4){bf2f((bf16)(w & 0xffffu)), bf2f((bf16)((w >> 16) & 0xffffu)), bf2f((bf16)((w >> 32) & 0xffffu)), bf2f((bf16)(w >> 48))}; }
        LDS_WAIT(); __syncthreads();
        const float g4 = expf(4.0f * lgam);
        const f32x4* S0 = (const f32x4*)(p.state_ret + (size_t)it * (RDK * RDV)) + ec; f32x4* S1 = (f32x4*)(p.out + O_SRS + (size_t)it * (RDK * RDV)) + ec;
        f32x4 oa[4] = {(f32x4){0.f, 0.f, 0.f, 0.f}, (f32x4){0.f, 0.f, 0.f, 0.f}, (f32x4){0.f, 0.f, 0.f, 0.f}, (f32x4){0.f, 0.f, 0.f, 0.f}};
#pragma unroll 1
        for (int d0 = dr; d0 < RDK; d0 += 32) {
            f32x4 sv[8];
#pragma unroll
            for (int u = 0; u < 8; ++u) sv[u] = __builtin_nontemporal_load(S0 + (size_t)(d0 + 4 * u) * (RDV / 4));
#pragma unroll
            for (int u = 0; u < 8; ++u) { const int d = d0 + 4 * u;
                const f32x4 k4 = *(const LAS f32x4*)(kd + d * 4), q4 = *(const LAS f32x4*)(qs + d * 4);
                const f32x4 sn = g4 * sv[u] + k4.x * vv[0] + k4.y * vv[1] + k4.z * vv[2] + k4.w * vv[3];
                __builtin_nontemporal_store(sn, S1 + (size_t)d * (RDV / 4));
                oa[0] += q4.x * sv[u]; oa[1] += q4.y * sv[u]; oa[2] += q4.z * sv[u]; oa[3] += q4.w * sv[u]; }
        }
#pragma unroll
        for (int t = 0; t < 4; ++t) *((LAS f32x4*)(op + (dr * 4 + t) * RDV) + ec) = oa[t];
        LDS_WAIT(); __syncthreads();
        { const int t = tid >> 7;
            f32x4 o = *((LAS f32x4*)(op + (0 * 4 + t) * RDV) + ec) + *((LAS f32x4*)(op + (1 * 4 + t) * RDV) + ec) + *((LAS f32x4*)(op + (2 * 4 + t) * RDV) + ec) + *((LAS f32x4*)(op + (3 * 4 + t) * RDV) + ec);
#pragma unroll
            for (int s = 0; s < 4; ++s) o += qk[t * 4 + s] * vv[s];
            *((f32x4*)(p.ORET + ((size_t)MP + (size_t)n * DS + t) * VW + h * RDV) + ec) = o; }
    }
    __syncthreads();
}
__device__ __forceinline__ void ret_scan_phase(const Ptrs& p, int tid) {
    using namespace cfg;
    for (int idx = blockIdx.x * NT + tid; idx < BATCH * RH * 512 * 64; idx += gridDim.x * NT) {
        const int d4 = idx & 63, e = (idx >> 6) & 511, nh = idx >> 15, h = nh % RH; const float cd = expf((float)RC * ret_log_gamma(h));
        f32x4 S = (f32x4){0.f, 0.f, 0.f, 0.f};
        const f32x4* u = (const f32x4*)(p.UT + ((size_t)nh * NSEG * 512 + e) * 256) + d4; unsigned long long* o = (unsigned long long*)(p.B2 + ((size_t)nh * NSEG * 512 + e) * 512 + 256) + d4;
#pragma unroll 8
        for (int seg = 0; seg < NSEG; ++seg) { const f32x4 uv = u[(size_t)seg * (512 * 256 / 4)];
            o[(size_t)seg * (512 * 512 / 4)] = (unsigned long long)pk2(S.x, S.y) | ((unsigned long long)pk2(S.z, S.w) << 32);
            S = cd * (S + uv); }
        float* fo = p.out + O_SRP + ((size_t)nh * RDK + 4 * d4) * RDV + e;
        fo[0] = S.x; fo[RDV] = S.y; fo[2 * RDV] = S.z; fo[3 * RDV] = S.w;
    }
}
#define PHASE_TID() int tid = TIDX(wave_s); asm volatile("" : "+v"(tid)); const int lane = tid & 63, wave = wave_s; (void)lane; (void)wave
#define IN(k) (lo <= (k) && (k) < hi)
#define SEAM(k) do { if (MK_ONE_LAUNCH && IN((k) + 1)) xcd_barrier(bar, wave_s); } while (0)
template <int L> __device__ __forceinline__ void layer_phases(LAS unsigned char* lds, const XcdBarrier& bar, const int lo, const int hi, const int G, const int wave_s) {
    using namespace cfg;
    constexpr int base = PH_L0 + PH_PER_LAYER * L;

        if (IN(base + S_G1A)) { const Ptrs p = kargs()->p;
            pg8::Gemm g{D, D, D}; pg8::StaticOrder S; S.init(p.XN, D, p.wfi_t + (size_t)(L * 2 + 0) * NFF * D, D, M, NFF, G, (int)blockIdx.x);
            pg8::EpiSwiglu E{p.H, FF};
            pg8::gemm_phase<pg8::EpiSwiglu, pg8::StaticOrder, true, true>(lds + RING_OFF, g, S, E, wave_s);
            SEAM(base + S_G1A);
        }
        if (IN(base + S_G2A)) { const Ptrs p = kargs()->p;
            pg8::Gemm g{FF, FF, FF}; pg8::StaticOrder S; S.init(p.H, FF, p.wfo_t + (size_t)(L * 2 + 0) * D * FF, FF, M, D, G, (int)blockIdx.x);
            pg8::EpiF32 E{p.Y, D, nullptr};
            pg8::gemm_phase<pg8::EpiF32, pg8::StaticOrder, true, true>(lds + RING_OFF, g, S, E, wave_s);
            SEAM(base + S_G2A);
        }
        if (IN(base + S_LNA)) { const Ptrs p = kargs()->p; PHASE_TID(); ln_rows_phase(p, L, 0, 0.5f, L, 1, wave, lane); SEAM(base + S_LNA); }
        if constexpr (L == 0) {
            if (IN(base + S_MIN)) {
                { const Ptrs p = kargs()->p; const pg8::RetBufs rb{p.A2, p.B2, p.KB, p.KT, p.GB, p.QS}; pg8::Gemm g{D, D, D}; pg8::OrdRetIn1 S{G, (int)blockIdx.x, (const char*)p.XN, (const char*)p.wri_t}; pg8::EpiRetIn1 E{rb};
                  pg8::gemm_phase<pg8::EpiRetIn1, pg8::OrdRetIn1, true, true>(lds + RING_OFF, g, S, E, wave_s); }
                { const Ptrs p = kargs()->p; const pg8::RetBufs rb{p.A2, p.B2, p.KB, p.KT, p.GB, p.QS}; pg8::Gemm g{D, D, D}; pg8::OrdRetIn2 S{G, (int)blockIdx.x, (const char*)(p.wri_t + (size_t)QKW * D), (const char*)p.XN}; pg8::EpiRetIn2 E{rb};
                  pg8::gemm_phase<pg8::EpiRetIn2, pg8::OrdRetIn2, true, true>(lds + RING_OFF, g, S, E, wave_s); }
                SEAM(base + S_MIN);
            }
            if (IN(base + S_MA)) {
                { const Ptrs p = kargs()->p; pg8::Gemm g{512, 256, 256};
                  typedef pg8::OrdBatch<2 * NITEM, 2, (size_t)512 * 512 * 2, (size_t)256 * 512 * 2, (size_t)256 * 256 * 2, 0, 512, 256, 0> Ord; Ord S{G, (int)blockIdx.x, (const char*)p.B2, (const char*)p.KT};
                  pg8::EpiF32 E{p.UT, 256, nullptr};
                  pg8::gemm_phase<pg8::EpiF32, Ord, true, true>(lds + RING_OFF, g, S, E, wave_s); }
                { const Ptrs p = kargs()->p; pg8::Gemm g{512, 256, 256};
                  typedef pg8::OrdBatch<NITEM, 1, (size_t)256 * 512 * 2, 0, (size_t)256 * 256 * 2, 0, 256, 0, 0> Ord; Ord S{G, (int)blockIdx.x, (const char*)(p.A2 + 256), (const char*)p.KB};
                  pg8::EpiMaskBf16 E{p.A2, 512};
                  pg8::gemm_phase<pg8::EpiMaskBf16, Ord, true, false>(lds + RING_OFF, g, S, E, wave_s); }
                { const Ptrs p = kargs()->p; PHASE_TID(); rets_phase(p, p.QS - (size_t)MP * (2 * QKW + VW), 2 * QKW + VW, lds + RING_OFF, tid, wave, lane); }
                SEAM(base + S_MA);
            }
            if (IN(base + S_MB)) { const Ptrs p = kargs()->p; PHASE_TID(); ret_scan_phase(p, tid); SEAM(base + S_MB); }
            if (IN(base + S_MC)) { const Ptrs p = kargs()->p;
                pg8::Gemm g{512, 512, 512}; pg8::OrdRetOut S{G, (int)blockIdx.x, (const char*)p.A2, (const char*)p.B2}; pg8::EpiF32 E{p.ORET, VW, nullptr};
                pg8::gemm_phase<pg8::EpiF32, pg8::OrdRetOut, true, true>(lds + RING_OFF, g, S, E, wave_s);
                SEAM(base + S_MC);
            }
            if (IN(base + S_MD)) { const Ptrs p = kargs()->p; PHASE_TID(); ret_gate_phase(p, p.GB, VW, wave, lane); SEAM(base + S_MD); }
            if (IN(base + S_MOUT)) { const Ptrs p = kargs()->p;
                pg8::Gemm g{VW, VW, VW}; pg8::StaticOrder S; S.init(p.AOB, VW, p.wro_t, VW, M, D, G, (int)blockIdx.x);
                pg8::EpiF32 E{p.Y, D, nullptr};
                pg8::gemm_phase<pg8::EpiF32, pg8::StaticOrder, true, true>(lds + RING_OFF, g, S, E, wave_s);
                SEAM(base + S_MOUT);
            }
        } else {
            if (IN(base + S_MIN)) { const Ptrs p = kargs()->p;
                pg8::Gemm g{D, D, D}; pg8::StaticOrder S; S.init(p.XN, D, p.wai_t, D, M, NATT, G, (int)blockIdx.x);
                pg8::EpiBf16<0> E{p.QKV, NATT, nullptr, 0, 0, 1.f};
                pg8::gemm_phase<pg8::EpiBf16<0>, pg8::StaticOrder, true, true>(lds + RING_OFF, g, S, E, wave_s);
                SEAM(base + S_MIN);
            }
            if (IN(base + S_MA)) { const Ptrs p = kargs()->p; PHASE_TID();
                GRID_ITEMS((long)M * NG * AH * (AD / 8), it_att(p, _i));
                GRID_ITEMS(kv_out_total(), it_kv_out(p, _i));
                SEAM(base + S_MA);
            }
            if (IN(base + S_MB)) { const Ptrs p = kargs()->p; PHASE_TID(); GRID_ITEMS((long)M * AO, it_att_merge(p, _i)); SEAM(base + S_MB + 2); }
            if (IN(base + S_MOUT)) { const Ptrs p = kargs()->p;
                pg8::Gemm g{AO, AO, AO}; pg8::StaticOrder S; S.init(p.OB, AO, p.wao_t, AO, M, D, G, (int)blockIdx.x);
                pg8::EpiF32 E{p.Y, D, nullptr};
                pg8::gemm_phase<pg8::EpiF32, pg8::StaticOrder, true, true>(lds + RING_OFF, g, S, E, wave_s);
                SEAM(base + S_MOUT);
            }
        }
        if (IN(base + S_LNM)) { const Ptrs p = kargs()->p; PHASE_TID(); ln_rows_phase(p, L, 1, 1.0f, L, 2, wave, lane); SEAM(base + S_LNM); }
        if (IN(base + S_G1B)) { const Ptrs p = kargs()->p;
            pg8::Gemm g{D, D, D}; pg8::StaticOrder S; S.init(p.XN, D, p.wfi_t + (size_t)(L * 2 + 1) * NFF * D, D, M, NFF, G, (int)blockIdx.x);
            pg8::EpiSwiglu E{p.H, FF};
            pg8::gemm_phase<pg8::EpiSwiglu, pg8::StaticOrder, true, true>(lds + RING_OFF, g, S, E, wave_s);
            SEAM(base + S_G1B);
        }
        if (IN(base + S_G2B)) { const Ptrs p = kargs()->p;
            pg8::Gemm g{FF, FF, FF}; pg8::StaticOrder S; S.init(p.H, FF, p.wfo_t + (size_t)(L * 2 + 1) * D * FF, FF, M, D, G, (int)blockIdx.x);
            pg8::EpiF32 E{p.Y, D, nullptr};
            pg8::gemm_phase<pg8::EpiF32, pg8::StaticOrder, true, true>(lds + RING_OFF, g, S, E, wave_s);
            SEAM(base + S_G2B);
        }
        if (IN(base + S_LNB)) { const Ptrs p = kargs()->p; PHASE_TID(); ln_rows_phase(p, L, 2, 0.5f, L + 1, L == 0 ? 0 : -1, wave, lane); SEAM(base + S_LNB); }
    }
#undef IN
#undef SEAM
__global__ void __launch_bounds__(NT, 2) fwd(Args args) {
    using namespace cfg;
    extern __shared__ __attribute__((aligned(16))) unsigned char lds_raw[];
    LAS unsigned char* lds = (LAS unsigned char*)lds_raw;
    volatile LAS unsigned* MISC = (volatile LAS unsigned*)(lds + MISC_OFF);
    const int G = gridDim.x;
    const int wave_s = __builtin_amdgcn_readfirstlane((int)threadIdx.x >> 6);
    for (int u = TIDX(wave_s); u < (LDS_BYTES - LDSCTL_OFF) / 4; u += NT) ((LAS unsigned*)(lds + LDSCTL_OFF))[u] = 0u;
    __syncthreads();
    XcdBarrier bar; { unsigned* const ctl = kargs()->p.ctl; bar.bar = ctl + CW_BAR; bar.x = 0; bar.st = nullptr;
    if (MK_ONE_LAUNCH) bar = xcd_barrier_post(ctl + CW_BAR, MISC + 8, wave_s); }
    const int lo = args.ph_lo, hi = args.ph_hi;
#define IN(k) (lo <= (k) && (k) < hi)
#define SEAM(k) do { if (MK_ONE_LAUNCH && IN((k) + 1)) xcd_barrier(bar, wave_s); } while (0)

    if (IN(PH_PRO)) { const Ptrs p = kargs()->p; PHASE_TID(); p0_prologue(p, lds, tid, wave, lane); SEAM(PH_PRO); }
    if (IN(PH_ADA)) { const Ptrs p = kargs()->p;
        pg8::Gemm g{D, D, D}; pg8::StaticOrder S; S.init(p.sc, D, p.wada_t, D, SCR, 18 * D, G, (int)blockIdx.x);
        pg8::EpiF32 E{p.ada, ADA_LD, p.b_ada};
        pg8::gemm_phase<pg8::EpiF32, pg8::StaticOrder, true, true>(lds + RING_OFF, g, S, E, wave_s);
        SEAM(PH_ADA);
    }
    if (IN(PH_MOD0)) { const Ptrs p = kargs()->p; PHASE_TID(); GRID_ITEMS((long)M * D, it_mod0(p, _i)); SEAM(PH_MOD0); }

    layer_phases<0>(lds, bar, lo, hi, G, wave_s);
    layer_phases<1>(lds, bar, lo, hi, G, wave_s);
#undef IN
#undef SEAM
}

extern "C" void kernel_launch(void* const* d_in, const int* in_sizes, int n_in, void* d_out, int out_size, void* d_ws, size_t ws_size, hipStream_t stream) {
    using namespace cfg;
    static int grid = 0;
    if (grid == 0) {
        const long want_out = O_KV0 + kv_out_total();
        if (n_in != 20 || (long)out_size != want_out || ws_size < wsm::END) { fprintf(stderr, "kernel_launch: shape mismatch: n_in %d out %d (want %ld) ws %zu (want %zu); nothing launched\n", n_in, out_size, want_out, ws_size, (size_t)wsm::END); grid = -1; return; }
        int dev = 0, cus = 0, per_cu = 0;
        if (hipGetDevice(&dev) != hipSuccess || hipDeviceGetAttribute(&cus, hipDeviceAttributeMultiprocessorCount, dev) != hipSuccess) { grid = -1; return; }
        if (hipFuncSetAttribute((const void*)fwd, hipFuncAttributeMaxDynamicSharedMemorySize, LDS_BYTES) != hipSuccess) { fprintf(stderr, "kernel_launch: hipFuncSetAttribute failed\n"); grid = -1; return; }
        if (hipOccupancyMaxActiveBlocksPerMultiprocessor(&per_cu, (const void*)fwd, NT, LDS_BYTES) != hipSuccess || per_cu < 1) fprintf(stderr, "kernel_launch: note: occupancy query reports %d workgroups per CU\n", per_cu);
        (void)hipGetLastError();
        grid = cus;
    }
    if (grid < 0) return;
    unsigned char* ws = (unsigned char*)d_ws;
    if (hipMemsetAsync(ws + wsm::CTL, 0, wsm::CTL_BYTES, stream) != hipSuccess) return;
    Args a{};
    Ptrs& p = a.p; const float* const* in = (const float* const*)d_in;
    p.x_prompt = in[0]; p.x_sample = in[1]; p.c_prompt = in[2]; p.c_sample = in[3]; p.state_ret = in[4]; p.cache0 = in[5]; p.cache1 = in[6]; p.cache2 = in[7];
    p.w_ada = in[8]; p.b_ada = in[9]; p.ln_g = in[10]; p.ln_b = in[11]; p.w_ffn_in = in[12]; p.w_ffn_out = in[13]; p.w_ret_in = in[14]; p.ret_gn_g = in[15]; p.ret_gn_b = in[16];
    p.w_ret_out = in[17]; p.w_att_in = in[18]; p.w_att_out = in[19];
    p.out = (float*)d_out; p.ctl = (unsigned*)(ws + wsm::CTL);
    p.wfi_t = (bf16*)(ws + wsm::WFI); p.wfo_t = (bf16*)(ws + wsm::WFO); p.wri_t = (bf16*)(ws + wsm::WRI); p.wro_t = (bf16*)(ws + wsm::WRO); p.wai_t = (bf16*)(ws + wsm::WAI); p.wao_t = (bf16*)(ws + wsm::WAO);
    p.wada_t = (bf16*)(ws + wsm::WADA); p.sc = (bf16*)(ws + wsm::SC); p.ada = (float*)(ws + wsm::ADA); p.X = (float*)(ws + wsm::X); p.Y = (float*)(ws + wsm::Y);
    p.XN = (bf16*)(ws + wsm::XN); p.H = (bf16*)(ws + wsm::H); p.QKV = (bf16*)(ws + wsm::QKV); p.AOB = (bf16*)(ws + wsm::AOB); p.OB = (bf16*)(ws + wsm::OB);
    p.U = (float*)(ws + wsm::U); p.SIN = (float*)(ws + wsm::SIN); p.PS = (float*)(ws + wsm::PS); p.ORET = (float*)(ws + wsm::ORET); p.OG = (float*)(ws + wsm::OG); p.LSE = (float*)(ws + wsm::LSE);
    p.A2 = (bf16*)(ws + wsm::A2); p.B2 = (bf16*)(ws + wsm::B2); p.KB = (bf16*)(ws + wsm::KB); p.KT = (bf16*)(ws + wsm::KT); p.UT = (float*)(ws + wsm::UT); p.GB = (bf16*)(ws + wsm::GB); p.QS = (bf16*)(ws + wsm::QS);
#if MK_ONE_LAUNCH
    a.ph_lo = 0; a.ph_hi = NPH;
    hipLaunchKernelGGL(fwd, dim3(grid), dim3(NT), LDS_BYTES, stream, a);
#else
    for (int ph = 0; ph < NPH; ++ph) {
        const int s = ph >= PH_L0 ? (ph - PH_L0) % PH_PER_LAYER : -1, L = ph >= PH_L0 ? (ph - PH_L0) / PH_PER_LAYER : -1;
        if (L == 1 && (s == S_MC || s == S_MD)) continue;
        a.ph_lo = ph; a.ph_hi = ph + 1;
        hipLaunchKernelGGL(fwd, dim3(grid), dim3(NT), LDS_BYTES, stream, a);
    }
#endif
    const hipError_t le = hipPeekAtLastError();
    if (le != hipSuccess) fprintf(stderr, "kernel_launch: launch failed: %s\n", hipGetErrorName(le));
}

#endif
```

```cpp
#ifndef HOST_SIM
#include <hip/hip_runtime.h>
#include <cstdio>
#include <cstdint>
#define HD __host__ __device__ __forceinline__
#else
#include <cmath>
#include <cstdio>
#include <cstdint>
#include <cstring>
#define HD inline
#endif

#ifndef CFG_D
#define CFG_D 1024
#define CFG_FF 2816
#define CFG_BATCH 2
#define CFG_SEQ 8192
#define CFG_DB 128
#define CFG_DS 4
#define CFG_PAST 2048
#define CFG_RH 4
#define CFG_RDK 256
#define CFG_RDV 512
#define CFG_RC 256
#define CFG_AH 8
#define CFG_AD 64
#define CFG_W0 128
#define CFG_DIL0 1
#define CFG_W1 512
#define CFG_DIL1 4
#define CFG_W2 2048
#define CFG_DIL2 16
#endif
namespace cfg {
constexpr int D = CFG_D, FF = CFG_FF, NFF = 2 * CFG_FF, BATCH = CFG_BATCH, SEQ = CFG_SEQ, DB = CFG_DB, DS = CFG_DS, PAST = CFG_PAST;
constexpr int MP = BATCH * SEQ, MS = DB * DS, M = MP + MS, NSEQ = BATCH + DB;
constexpr int RH = CFG_RH, RDK = CFG_RDK, RDV = CFG_RDV, RC = CFG_RC, QKW = RH * RDK, VW = RH * RDV, NRET = 2 * QKW + 2 * VW;
constexpr int NSEG = SEQ / RC, NITEM = BATCH * RH * NSEG;
constexpr int AH = CFG_AH, AD = CFG_AD, AO = AH * AD, NG = 3, NATT = 3 * NG * AO;
constexpr int SCR = ((NSEQ + 255) / 256) * 256;
constexpr int ADA_LD = 18 * D;
constexpr float LN_EPS = 1e-5f;
constexpr float ALPHA = 1.41421356237309515f;
HD int win(int g) { return g == 0 ? CFG_W0 : (g == 1 ? CFG_W1 : CFG_W2); }
HD int dil(int g) { return g == 0 ? CFG_DIL0 : (g == 1 ? CFG_DIL1 : CFG_DIL2); }
HD int nback(int g) { return win(g) / dil(g); }
HD int lbuf(int g) { return win(g) < PAST ? win(g) : PAST; }
HD int keep(int g) { return win(g) < SEQ ? win(g) : SEQ; }
constexpr long O_YP = 0, O_YS = O_YP + (long)MP * D, O_SRP = O_YS + (long)MS * D, O_SRS = O_SRP + (long)BATCH * RH * RDK * RDV, O_KV0 = O_SRS + (long)DB * RH * RDK * RDV;
}

typedef unsigned short bf16;
HD unsigned f2bf_u(float f) { unsigned u = __builtin_bit_cast(unsigned, f); return (u + 0x7fffu + ((u >> 16) & 1u)) >> 16; }
HD bf16 f2bf(float f) { return (bf16)f2bf_u(f); }
HD float bf2f(bf16 h) { unsigned u = (unsigned)h << 16; return __builtin_bit_cast(float, u); }
HD float silu_f(float x) { return x / (1.0f + expf(-x)); }
HD float swiglu_f(float a, float b) { return silu_f(a) * b; }
HD int seq_of_row(int m) { return m < cfg::MP ? m / cfg::SEQ : cfg::BATCH + (m - cfg::MP) / cfg::DS; }
HD float ret_log_gamma(int h) { return log1pf(-exp2f(-5.0f - (float)h)); }
HD float ret_pow(int h, float n) { return expf(n * ret_log_gamma(h)); }
HD float alibi_slope(int g, int head) { return exp2f(-8.0f * (float)(g * cfg::AH + head + 1) / (float)(cfg::NG * cfg::AH)); }
HD int ffn_dst_of_src(int c) { const int half = c / cfg::FF, j = c % cfg::FF; return 256 * (j / 128) + 128 * half + (j % 128); }
HD int ffn_src_of_dst(int r) { const int p = r / 256, rr = r % 256, half = rr / 128; return half * cfg::FF + 128 * p + rr % 128; }

struct Ptrs {
    const float *x_prompt, *x_sample, *c_prompt, *c_sample, *state_ret, *cache0, *cache1, *cache2, *w_ada, *b_ada, *ln_g, *ln_b, *w_ffn_in, *w_ffn_out, *w_ret_in, *ret_gn_g, *ret_gn_b, *w_ret_out, *w_att_in, *w_att_out;
    float* out;
    unsigned* ctl;
    bf16 *wfi_t, *wfo_t, *wri_t, *wro_t, *wai_t, *wao_t, *wada_t;
    bf16 *sc;
    float *ada;
    float *X, *Y;
    bf16 *XN, *H, *QKV, *AOB, *OB;
    float *U, *SIN, *PS, *ORET, *OG, *LSE;
    bf16 *A2, *B2, *KB, *KT, *GB, *QS; float* UT;
};

HD const float* cache_ptr(const Ptrs& p, int g) { const uintptr_t m0 = (uintptr_t)0 - (uintptr_t)(g == 0), m1 = (uintptr_t)0 - (uintptr_t)(g == 1), m2 = (uintptr_t)0 - (uintptr_t)(g == 2); return (const float*)(((uintptr_t)p.cache0 & m0) | ((uintptr_t)p.cache1 & m1) | ((uintptr_t)p.cache2 & m2)); }
HD void it_silu_c(const Ptrs& p, long i) {
    using namespace cfg; const int r = (int)(i / D), k = (int)(i % D); float v = 0.f;
    if (r < NSEQ) v = silu_f(r < BATCH ? p.c_prompt[(long)r * D + k] : p.c_sample[(long)(r - BATCH) * D + k]);
    p.sc[i] = f2bf(v);
}
HD const float* ada_vec(const Ptrs& p, int seq, int layer, int j, int which) { return p.ada + (size_t)seq * cfg::ADA_LD + layer * 9 * cfg::D + (j * 3 + which) * cfg::D; }
HD void it_mod0(const Ptrs& p, long i) {
    using namespace cfg; const int m = (int)(i / D), c = (int)(i % D);
    const float x = m < MP ? p.x_prompt[i] : p.x_sample[i - (long)MP * D];
    const int s = seq_of_row(m);
    p.X[i] = x; p.XN[i] = f2bf(x * (1.0f + ada_vec(p, s, 0, 0, 1)[c]) + ada_vec(p, s, 0, 0, 0)[c]);
}
HD void it_ln_row(const Ptrs& p, int m, int layer, int j, float coef, int nl, int nj) {
    using namespace cfg; const int s = seq_of_row(m); const float* gate = ada_vec(p, s, layer, j, 2);
    float* X = p.X + (size_t)m * D; const float* Y = p.Y + (size_t)m * D;
    const float* lg = p.ln_g + (size_t)(layer * 3 + j) * D; const float* lb = p.ln_b + (size_t)(layer * 3 + j) * D;
    float sum = 0.f; for (int c = 0; c < D; ++c) sum += ALPHA * X[c] + coef * (1.0f + gate[c]) * Y[c];
    const float mu = sum / (float)D; float sq = 0.f;
    for (int c = 0; c < D; ++c) { const float z = ALPHA * X[c] + coef * (1.0f + gate[c]) * Y[c] - mu; sq += z * z; }
    const float rstd = 1.0f / sqrtf(sq / (float)D + LN_EPS);
    if (nj >= 0) { const float* sh = ada_vec(p, s, nl, nj, 0); const float* sc = ada_vec(p, s, nl, nj, 1); bf16* XN = p.XN + (size_t)m * D;
        for (int c = 0; c < D; ++c) { const float z = ALPHA * X[c] + coef * (1.0f + gate[c]) * Y[c]; const float xn = (z - mu) * rstd * lg[c] + lb[c]; X[c] = xn; XN[c] = f2bf(xn * (1.0f + sc[c]) + sh[c]); } }
    else { float* o = p.out + (size_t)m * D;
        for (int c = 0; c < D; ++c) { const float z = ALPHA * X[c] + coef * (1.0f + gate[c]) * Y[c]; o[c] = (z - mu) * rstd * lg[c] + lb[c]; } }
}
HD void ret_item(int it, int& n, int& h, int& seg) { using namespace cfg; n = it / (RH * NSEG); h = (it / NSEG) % RH; seg = it % NSEG; }
HD void it_ret_local(const Ptrs& p, long i) {
    using namespace cfg; const int it = (int)(i / (RDK * RDV)), d = (int)(i / RDV) % RDK, e = (int)(i % RDV); int n, h, seg; ret_item(it, n, h, seg);
    const size_t m0 = (size_t)n * SEQ + (size_t)seg * RC; const float ks = 1.0f / sqrtf((float)RDK); float acc = 0.f;
    for (int s = 0; s < RC; ++s) { const bf16* row = p.QKV + (m0 + s) * NRET; acc += ret_pow(h, (float)(RC - 1 - s)) * ks * bf2f(row[QKW + h * RDK + d]) * bf2f(row[2 * QKW + h * RDV + e]); }
    p.U[i] = acc;
}
HD void it_ret_scan(const Ptrs& p, long i) {
    using namespace cfg; const int nh = (int)(i / (RDK * RDV)); const long de = i % (RDK * RDV); const int h = nh % RH; const float cd = ret_pow(h, (float)RC); float S = 0.f;
    for (int seg = 0; seg < NSEG; ++seg) { const size_t o = ((size_t)nh * NSEG + seg) * (RDK * RDV) + de; p.SIN[o] = S; S = cd * S + p.U[o]; }
    p.out[O_SRP + i] = S;
}
HD void it_ret_scores(const Ptrs& p, long i) {
    using namespace cfg; const int it = (int)(i / (RC * RC)), t = (int)(i / RC) % RC, s = (int)(i % RC); int n, h, seg; ret_item(it, n, h, seg);
    float v = 0.f;
    if (s <= t) { const size_t m0 = (size_t)n * SEQ + (size_t)seg * RC; const bf16* q = p.QKV + (m0 + t) * NRET + h * RDK; const bf16* k = p.QKV + (m0 + s) * NRET + QKW + h * RDK; float acc = 0.f;
        for (int d = 0; d < RDK; ++d) acc += bf2f(q[d]) * bf2f(k[d]);
        v = acc * (1.0f / sqrtf((float)RDK)) * ret_pow(h, (float)(t - s)); }
    p.PS[i] = v;
}
HD void it_ret_out(const Ptrs& p, long i) {
    using namespace cfg; const int it = (int)(i / (RC * RDV)), t = (int)(i / RDV) % RC, e = (int)(i % RDV); int n, h, seg; ret_item(it, n, h, seg);
    const size_t m0 = (size_t)n * SEQ + (size_t)seg * RC; const float* P = p.PS + ((size_t)it * RC + t) * RC; float acc = 0.f;
    for (int s = 0; s <= t; ++s) acc += P[s] * bf2f(p.QKV[(m0 + s) * NRET + 2 * QKW + h * RDV + e]);
    const bf16* q = p.QKV + (m0 + t) * NRET + h * RDK; const float* S = p.SIN + (size_t)it * (RDK * RDV) + e; float a2 = 0.f;
    for (int d = 0; d < RDK; ++d) a2 += bf2f(q[d]) * S[(size_t)d * RDV];
    p.ORET[(m0 + t) * VW + h * RDV + e] = acc + ret_pow(h, (float)(t + 1)) * a2;
}
HD void it_rets_state(const Ptrs& p, long i) {
    using namespace cfg; const int nh = (int)(i / (RDK * RDV)), n = nh / RH, h = nh % RH, d = (int)(i / RDV) % RDK, e = (int)(i % RDV);
    const float ks = 1.0f / sqrtf((float)RDK); float acc = ret_pow(h, (float)DS) * p.state_ret[i];
    for (int s = 0; s < DS; ++s) { const bf16* row = p.QKV + ((size_t)MP + (size_t)n * DS + s) * NRET; acc += ret_pow(h, (float)(DS - 1 - s)) * ks * bf2f(row[QKW + h * RDK + d]) * bf2f(row[2 * QKW + h * RDV + e]); }
    p.out[O_SRS + i] = acc;
}
HD void it_rets_out(const Ptrs& p, long i) {
    using namespace cfg; const int ms = (int)(i / (RH * RDV)), h = (int)(i / RDV) % RH, e = (int)(i % RDV), n = ms / DS, t = ms % DS;
    const size_t r0 = (size_t)MP + (size_t)n * DS; const bf16* q = p.QKV + (r0 + t) * NRET + h * RDK; const float ks = 1.0f / sqrtf((float)RDK); float acc = 0.f;
    for (int s = 0; s <= t; ++s) { const bf16* k = p.QKV + (r0 + s) * NRET + QKW + h * RDK; float qk = 0.f; for (int d = 0; d < RDK; ++d) qk += bf2f(q[d]) * bf2f(k[d]);
        acc += qk * ks * ret_pow(h, (float)(t - s)) * bf2f(p.QKV[(r0 + s) * NRET + 2 * QKW + h * RDV + e]); }
    const float* S = p.state_ret + ((size_t)n * RH + h) * (RDK * RDV) + e; float a2 = 0.f;
    for (int d = 0; d < RDK; ++d) a2 += bf2f(q[d]) * S[(size_t)d * RDV];
    p.ORET[(r0 + t) * VW + h * RDV + e] = acc + ret_pow(h, (float)(t + 1)) * a2;
}
HD void it_ret_gate(const Ptrs& p, long i) {
    using namespace cfg; const size_t m = (size_t)(i / RH); const int h = (int)(i % RH); const float* o = p.ORET + m * VW + h * RDV; float sum = 0.f;
    for (int e = 0; e < RDV; ++e) sum += o[e];
    const float mu = sum / (float)RDV; float sq = 0.f; for (int e = 0; e < RDV; ++e) { const float z = o[e] - mu; sq += z * z; }
    const float rstd = 1.0f / sqrtf(sq / (float)RDV + LN_EPS); const bf16* g = p.QKV + m * NRET + 2 * QKW + VW + h * RDV;
    for (int e = 0; e < RDV; ++e) p.AOB[m * VW + h * RDV + e] = f2bf(silu_f(bf2f(g[e])) * ((o[e] - mu) * rstd * p.ret_gn_g[h * RDV + e] + p.ret_gn_b[h * RDV + e]));
}
HD void it_att(const Ptrs& p, long i) {
    using namespace cfg; const int dc = (int)(i % (AD / 8)), head = (int)(i / (AD / 8)) % AH, g = (int)(i / (AD / 8 * AH)) % NG; const int m = (int)(i / (AD / 8 * AH * NG));
    const int dl = dil(g), nb = nback(g), lb = lbuf(g); const float slope = alibi_slope(g, head) * (float)dl, scale = 1.0f / sqrtf((float)AD);
    const bf16* q = p.QKV + (size_t)m * NATT + g * AO + head * AD;
    float mx = -INFINITY, l = 0.f, a0 = 0.f, a1 = 0.f, a2 = 0.f, a3 = 0.f, a4 = 0.f, a5 = 0.f, a6 = 0.f, a7 = 0.f;
    const bool prompt = m < MP; const int t = prompt ? m % SEQ : (m - MP) % DS; const int nsmp = prompt ? 0 : (m - MP) / DS;
    for (int j = 0; j <= nb; ++j) {
        const bf16* kb = nullptr; const float* kf = nullptr;
        if (prompt) { const int pos = t - j * dl; if (pos < 0) break; kb = p.QKV + (size_t)(m - j * dl) * NATT + 3 * AO + g * AO + head * AD; }
        else { const int idx = lb + t - j * dl; if (idx < 0) break;
            if (idx >= lb) kb = p.QKV + ((size_t)MP + (size_t)nsmp * DS + (idx - lb)) * NATT + 3 * AO + g * AO + head * AD;
            else kf = cache_ptr(p, g) + (((size_t)nsmp * lb + idx) * 2) * AO + head * AD; }
        float sc = 0.f, v0, v1, v2, v3, v4, v5, v6, v7;
        if (kb) { for (int d = 0; d < AD; ++d) sc += bf2f(q[d]) * bf2f(kb[d]); const bf16* vb = kb + 3 * AO + dc * 8;
            v0 = bf2f(vb[0]); v1 = bf2f(vb[1]); v2 = bf2f(vb[2]); v3 = bf2f(vb[3]); v4 = bf2f(vb[4]); v5 = bf2f(vb[5]); v6 = bf2f(vb[6]); v7 = bf2f(vb[7]); }
        else { for (int d = 0; d < AD; ++d) sc += bf2f(q[d]) * kf[d]; const float* vf = kf + AO + dc * 8;
            v0 = vf[0]; v1 = vf[1]; v2 = vf[2]; v3 = vf[3]; v4 = vf[4]; v5 = vf[5]; v6 = vf[6]; v7 = vf[7]; }
        sc = sc * scale - slope * (float)j;
        const float mn = sc > mx ? sc : mx, f = expf(mx - mn), pj = expf(sc - mn);
        l = l * f + pj; mx = mn;
        a0 = a0 * f + pj * v0; a1 = a1 * f + pj * v1; a2 = a2 * f + pj * v2; a3 = a3 * f + pj * v3; a4 = a4 * f + pj * v4; a5 = a5 * f + pj * v5; a6 = a6 * f + pj * v6; a7 = a7 * f + pj * v7;
    }
    float* o = p.OG + ((size_t)g * M + m) * AO + head * AD + dc * 8; const float rl = 1.0f / l;
    o[0] = a0 * rl; o[1] = a1 * rl; o[2] = a2 * rl; o[3] = a3 * rl; o[4] = a4 * rl; o[5] = a5 * rl; o[6] = a6 * rl; o[7] = a7 * rl;
    if (dc == 0) p.LSE[((size_t)g * M + m) * AH + head] = mx + logf(l);
}
HD void it_att_merge(const Ptrs& p, long i) {
    using namespace cfg; const size_t m = (size_t)(i / AO); const int c = (int)(i % AO), head = c / AD;
    const float l0 = p.LSE[((size_t)0 * M + m) * AH + head], l1 = p.LSE[((size_t)1 * M + m) * AH + head], l2 = p.LSE[((size_t)2 * M + m) * AH + head];
    const float mx = fmaxf(l0, fmaxf(l1, l2)), w0 = expf(l0 - mx), w1 = expf(l1 - mx), w2 = expf(l2 - mx);
    const float acc = w0 * p.OG[((size_t)0 * M + m) * AO + c] + w1 * p.OG[((size_t)1 * M + m) * AO + c] + w2 * p.OG[((size_t)2 * M + m) * AO + c];
    p.OB[i] = f2bf(acc / (w0 + w1 + w2));
}
HD void it_kv_out(const Ptrs& p, long i) {
    using namespace cfg; long r = i;
    for (int g = 0; g < NG; ++g) {
        const long np = (long)BATCH * keep(g) * 2 * AO, ns = (long)MS * 2 * AO;
        if (r < np) { const int c = (int)(r % AO), kv = (int)(r / AO) % 2, row = (int)(r / (2 * AO)) % keep(g), n = (int)(r / ((long)2 * AO * keep(g)));
            const size_t m = (size_t)n * SEQ + (SEQ - keep(g)) + row; p.out[O_KV0 + i] = bf2f(p.QKV[m * NATT + (1 + kv) * 3 * AO + g * AO + c]); return; }
        r -= np;
        if (r < ns) { const int c = (int)(r % AO), kv = (int)(r / AO) % 2; const size_t m = (size_t)MP + (size_t)(r / (2 * AO)); p.out[O_KV0 + i] = bf2f(p.QKV[m * NATT + (1 + kv) * 3 * AO + g * AO + c]); return; }
        r -= ns;
    }
}
HD long kv_out_total() { using namespace cfg; long t = 0; for (int g = 0; g < NG; ++g) t += (long)BATCH * keep(g) * 2 * AO + (long)MS * 2 * AO; return t; }

#ifndef HOST_SIM
namespace pg8 {
#define PG8_LAS __attribute__((address_space(3)))
typedef unsigned short bf16_t;
typedef short bf16x8 __attribute__((ext_vector_type(8)));
typedef float f32x4 __attribute__((ext_vector_type(4)));
typedef unsigned u32x4 __attribute__((ext_vector_type(4)));
constexpr int BM = 256, BK = 64, HALF = 128, HTB = HALF * BK * 2  , STAGE_BYTES = 8 * HTB, NXCD = 8, WGM = 8;

__host__ __device__ __forceinline__ int lds_byte(int r, int c) { const int st = (r >> 4) * 2 + (c >> 5), rr = r & 15, cc = c & 31, ob = rr * 64 + cc * 2; return st * 1024 + (ob ^ (((ob >> 9) & 1) << 5)); }
__host__ __device__ __forceinline__ void stage_rc(int b, int& R, int& C) { const int st = b / 1024, sb = b % 1024, swz = sb ^ (((sb >> 9) & 1) << 5); R = (st >> 1) * 16 + swz / 64; C = (st & 1) * 32 + (swz % 64) / 2; }
__host__ __device__ __forceinline__ int perm32(int rho) { const int n = rho >> 4, i = rho & 15; return 8 * (i >> 2) + 4 * n + (i & 3); }

struct Unit { const char* a; const char* b; int pm, pn, ro, co, id; };
struct Gemm { int lda, ldb, K; };

struct StaticOrder {
    int nM, nN, nwg, G, c; const char* A; const char* Bt; size_t ta, tb;
    __host__ __device__ void init(const bf16_t* A_, int lda, const bf16_t* Bt_, int ldb, int M, int N, int G_, int c_) { nM = M / BM; nN = N / BM; nwg = nM * nN; G = G_; c = c_; A = (const char*)A_; Bt = (const char*)Bt_; ta = (size_t)BM * lda * 2; tb = (size_t)BM * ldb * 2; }
    __host__ __device__ bool next(int i, Unit& u) const {
        const long L = (long)i * G + c; if (L >= nwg) return false;
        int wgid = (int)L; { const int q = nwg / NXCD, r = nwg % NXCD, xcd = wgid % NXCD, off = wgid / NXCD; wgid = (xcd < r ? xcd * (q + 1) : r * (q + 1) + (xcd - r) * q) + off; }
        const int nig = WGM * nN, gid = wgid / nig, fm = gid * WGM, gsz = (nM - fm) < WGM ? (nM - fm) : WGM;
        u.pm = fm + ((wgid % nig) % gsz); u.pn = (wgid % nig) / gsz; u.a = A + (size_t)u.pm * ta; u.b = Bt + (size_t)u.pn * tb; u.ro = u.pm * BM; u.co = u.pn * BM; u.id = 0; return true;
    }
    __device__ __forceinline__ void a_ready(const Unit&) const {}
    __device__ __forceinline__ void done(const Unit&) const {}
};

__device__ __forceinline__ unsigned cvt_pk_bf16(float lo, float hi) { unsigned r; asm volatile("v_cvt_pk_bf16_f32 %0, %1, %2" : "=v"(r) : "v"(lo), "v"(hi)); return r; }
typedef float f32x2 __attribute__((ext_vector_type(2)));
__device__ __forceinline__ f32x2 gelu_pk(f32x2 v) {
    const f32x2 av = __builtin_elementwise_abs(v), d = av * 0.2316418882f + 1.0f;
    f32x2 t; t.x = __builtin_amdgcn_rcpf(d.x); t.y = __builtin_amdgcn_rcpf(d.y);
    f32x2 q = t * 0.5307027145f + (-0.7265760135f); q = q * t + 0.7107068705f; q = q * t + (-0.142248368f); q = q * t + 0.127414796f; q = q * t;
    const f32x2 s = (v * v) * (-0.72134752044f);
    f32x2 e; e.x = __builtin_amdgcn_exp2f(s.x); e.y = __builtin_amdgcn_exp2f(s.y);
    const f32x2 m = v * (q * e), r = v - m;
    f32x2 o; o.x = v.x < 0.f ? m.x : r.x; o.y = v.y < 0.f ? m.y : r.y; return o;
}

template <int ACT  > struct EpiBf16 {
    static constexpr bool PERM = true, AFTER_DRAIN = false; static_assert(ACT == 0 || ACT == 1, "EpiBf16: ACT is 0 (none) or 1 (gelu_pk)");
    bf16_t* O; int ldc; const float* bias; int split_cols; size_t split_stride; float scale0;
    __device__ __forceinline__ void operator()(const f32x4 (&acc)[2][2][4][2], const Unit& u, int wr, int wc, int fr, int fq) const {
        const int row0 = u.ro + wr * 64 + fr; int colt = u.co; bf16_t* base = O;
        float sc = 1.f; if (split_cols) { const int t = colt / split_cols; base += (size_t)t * split_stride; colt -= t * split_cols; if (t == 0) sc = scale0; }
        const int col0 = colt + wc * 32 + 8 * fq, bcol0 = u.co + wc * 32 + 8 * fq;
        f32x4 bv[2][2];
#pragma unroll
        for (int bj = 0; bj < 2; ++bj)
#pragma unroll
            for (int n = 0; n < 2; ++n) bv[bj][n] = bias ? *(const f32x4*)(bias + bcol0 + bj * HALF + 4 * n) : (f32x4){0.f, 0.f, 0.f, 0.f};
#pragma unroll
        for (int ai = 0; ai < 2; ++ai)
#pragma unroll
            for (int m = 0; m < 4; ++m) { bf16_t* rowp = base + (size_t)(row0 + ai * HALF + m * 16) * ldc + col0;
#pragma unroll
                for (int bj = 0; bj < 2; ++bj) { f32x4 v0 = acc[ai][bj][m][0] + bv[bj][0], v1 = acc[ai][bj][m][1] + bv[bj][1];
                    if (ACT == 1) { f32x2 a = gelu_pk((f32x2){v0[0], v0[1]}), b = gelu_pk((f32x2){v0[2], v0[3]}), c = gelu_pk((f32x2){v1[0], v1[1]}), d = gelu_pk((f32x2){v1[2], v1[3]});
                        v0 = (f32x4){a.x, a.y, b.x, b.y}; v1 = (f32x4){c.x, c.y, d.x, d.y}; }
                    v0 = v0 * sc; v1 = v1 * sc; u32x4 w; w.x = cvt_pk_bf16(v0[0], v0[1]); w.y = cvt_pk_bf16(v0[2], v0[3]); w.z = cvt_pk_bf16(v1[0], v1[1]); w.w = cvt_pk_bf16(v1[2], v1[3]);
                    *(u32x4*)(rowp + bj * HALF) = w; } }
    }
};

struct EpiF32 {
    static constexpr bool PERM = false, AFTER_DRAIN = false;
    float* C; int ldc; const float* bias;
    __device__ __forceinline__ void operator()(const f32x4 (&acc)[2][2][4][2], const Unit& u, int wr, int wc, int fr, int fq) const {
        const int row0 = u.ro + wr * 64 + fr, col0 = u.co + wc * 32 + 4 * fq;
        f32x4 bv[2][2];
#pragma unroll
        for (int bj = 0; bj < 2; ++bj)
#pragma unroll
            for (int n = 0; n < 2; ++n) bv[bj][n] = bias ? *(const f32x4*)(bias + col0 + bj * HALF + n * 16) : (f32x4){0.f, 0.f, 0.f, 0.f};
#pragma unroll
        for (int ai = 0; ai < 2; ++ai)
#pragma unroll
            for (int m = 0; m < 4; ++m) { float* rowp = C + (size_t)(row0 + ai * HALF + m * 16) * ldc + col0;
#pragma unroll
                for (int bj = 0; bj < 2; ++bj)
#pragma unroll
                    for (int n = 0; n < 2; ++n) *(f32x4*)(rowp + bj * HALF + n * 16) = acc[ai][bj][m][n] + bv[bj][n]; }
    }
};
struct EpiSwiglu {
    static constexpr bool PERM = true, AFTER_DRAIN = false;
    bf16_t* O; int ldc;
    __device__ __forceinline__ void operator()(const f32x4 (&acc)[2][2][4][2], const Unit& u, int wr, int wc, int fr, int fq) const {
        const int row0 = u.ro + wr * 64 + fr, col0 = (u.co >> 1) + wc * 32 + 8 * fq;
#pragma unroll
        for (int ai = 0; ai < 2; ++ai)
#pragma unroll
            for (int m = 0; m < 4; ++m) { bf16_t* rowp = O + (size_t)(row0 + ai * HALF + m * 16) * ldc + col0;
                const f32x4 a0 = acc[ai][0][m][0], a1 = acc[ai][0][m][1], b0 = acc[ai][1][m][0], b1 = acc[ai][1][m][1];
                u32x4 w; w.x = cvt_pk_bf16(swiglu_f(a0[0], b0[0]), swiglu_f(a0[1], b0[1])); w.y = cvt_pk_bf16(swiglu_f(a0[2], b0[2]), swiglu_f(a0[3], b0[3]));
                w.z = cvt_pk_bf16(swiglu_f(a1[0], b1[0]), swiglu_f(a1[1], b1[1])); w.w = cvt_pk_bf16(swiglu_f(a1[2], b1[2]), swiglu_f(a1[3], b1[3]));
                *(u32x4*)rowp = w; }
    }
};
struct RetBufs { bf16_t *A2, *B2, *KB, *KT, *GB, *QS; };
__device__ __forceinline__ float ret_l2g(int h) { return ret_log_gamma(h) * 1.44269504088896341f; }
struct OrdRetIn1 {
    int G, c; const char* A; const char* Bt;
    __device__ __forceinline__ bool next(int i, Unit& u) const {
        using namespace cfg; constexpr int NP = MP / 256, NPU = NP * 16, NSU = (MS / 256) * 24;
        const long L = (long)i * G + c; if (L >= NPU + NSU) return false;
        if (L < NPU) { u.pm = (int)L / 16; const int j = (int)L % 16; u.pn = j < 8 ? j : j + 8; } else { const int l = (int)L - NPU; u.pm = NP + l / 24; u.pn = l % 24; }
        u.a = A + (size_t)u.pm * (256 * D * 2); u.b = Bt + (size_t)u.pn * (256 * D * 2); u.ro = u.pm * 256; u.co = u.pn * 256; u.id = 0; return true;
    }
    __device__ __forceinline__ void a_ready(const Unit&) const {}
    __device__ __forceinline__ void done(const Unit&) const {}
};
struct EpiRetIn1 {
    static constexpr bool PERM = true, AFTER_DRAIN = false;
    RetBufs rb;
    __device__ __forceinline__ void operator()(const f32x4 (&acc)[2][2][4][2], const Unit& u, int wr, int wc, int fr, int fq) const {
        using namespace cfg; constexpr int NP = MP / 256;
        const int pm = u.pm, pn = u.pn, rl0 = wr * 64 + fr, cl0 = wc * 32 + 8 * fq;
        bf16_t* base; int ld; float l2g = 0.f, f0 = 1.f;
        if (pm < NP && pn < 8) { const int n = pm / NSEG, seg = pm % NSEG, h = pn & 3; const size_t it = ((size_t)n * RH + h) * NSEG + seg;
            if (pn < 4) { base = rb.A2 + it * (256 * 512) + 256; ld = 512; l2g = ret_l2g(h); }
            else { base = rb.KB + it * (256 * 256); ld = 256; l2g = -ret_l2g(h); f0 = 1.0f / 16.0f; } }
        else if (pn >= 16) { base = rb.GB + (size_t)pm * 256 * VW + (pn - 16) * 256; ld = VW; }
        else { base = rb.QS + (size_t)(pm - NP) * 256 * (2 * QKW + VW) + pn * 256; ld = 2 * QKW + VW; }
#pragma unroll
        for (int ai = 0; ai < 2; ++ai)
#pragma unroll
            for (int m = 0; m < 4; ++m) { const int tl = rl0 + ai * HALF + m * 16; const float f = f0 * exp2f(l2g * (float)(tl + 1)); bf16_t* rowp = base + (size_t)tl * ld + cl0;
#pragma unroll
                for (int bj = 0; bj < 2; ++bj) { const f32x4 v0 = acc[ai][bj][m][0] * f, v1 = acc[ai][bj][m][1] * f;
                    u32x4 w; w.x = cvt_pk_bf16(v0[0], v0[1]); w.y = cvt_pk_bf16(v0[2], v0[3]); w.z = cvt_pk_bf16(v1[0], v1[1]); w.w = cvt_pk_bf16(v1[2], v1[3]);
                    *(u32x4*)(rowp + bj * HALF) = w; } }
    }
};
struct OrdRetIn2 {
    int G, c; const char* A; const char* Bt;
    __device__ __forceinline__ bool next(int i, Unit& u) const {
        using namespace cfg; constexpr int NF = (QKW + VW) / 256, NU = NF * (MP / 256);
        const long L = (long)i * G + c; if (L >= NU) return false;
        u.pm = (int)L % NF; u.pn = (int)L / NF; u.a = A + (size_t)u.pm * (256 * D * 2); u.b = Bt + (size_t)u.pn * (256 * D * 2); u.ro = u.pm * 256; u.co = u.pn * 256; u.id = 0; return true;
    }
    __device__ __forceinline__ void a_ready(const Unit&) const {}
    __device__ __forceinline__ void done(const Unit&) const {}
};
struct EpiRetIn2 {
    static constexpr bool PERM = true, AFTER_DRAIN = false;
    RetBufs rb;
    __device__ __forceinline__ void operator()(const f32x4 (&acc)[2][2][4][2], const Unit& u, int wr, int wc, int fr, int fq) const {
        using namespace cfg;
        const int pm = u.pm, pn = u.pn, rl0 = wr * 64 + fr, cl0 = wc * 32 + 8 * fq, n = pn / NSEG, seg = pn % NSEG;
        bf16_t* base; int ld; float l2g = 0.f, f0 = 1.f;
        if (pm < 4) { const int h = pm; const size_t it = ((size_t)n * RH + h) * NSEG + seg; base = rb.KT + it * (256 * 256); ld = 256; l2g = -ret_l2g(h); f0 = 1.0f / 16.0f; }
        else { const int h = (pm - 4) >> 1, eh = (pm - 4) & 1; const size_t it = ((size_t)n * RH + h) * NSEG + seg; base = rb.B2 + (it * 512 + eh * 256) * 512; ld = 512; }
        float f[2][8];
#pragma unroll
        for (int bj = 0; bj < 2; ++bj)
#pragma unroll
            for (int j = 0; j < 8; ++j) f[bj][j] = f0 * exp2f(l2g * (float)(cl0 + bj * HALF + j + 1));
#pragma unroll
        for (int ai = 0; ai < 2; ++ai)
#pragma unroll
            for (int m = 0; m < 4; ++m) { bf16_t* rowp = base + (size_t)(rl0 + ai * HALF + m * 16) * ld + cl0;
#pragma unroll
                for (int bj = 0; bj < 2; ++bj) { const f32x4 v0 = acc[ai][bj][m][0], v1 = acc[ai][bj][m][1];
                    u32x4 w; w.x = cvt_pk_bf16(v0[0] * f[bj][0], v0[1] * f[bj][1]); w.y = cvt_pk_bf16(v0[2] * f[bj][2], v0[3] * f[bj][3]);
                    w.z = cvt_pk_bf16(v1[0] * f[bj][4], v1[1] * f[bj][5]); w.w = cvt_pk_bf16(v1[2] * f[bj][6], v1[3] * f[bj][7]);
                    *(u32x4*)(rowp + bj * HALF) = w; } }
    }
};
template <int NU, int PER, size_t SA, size_t PA, size_t SB, size_t PB, int RI, int RP, int CP> struct OrdBatch {
    int G, c; const char* A; const char* Bt;
    __device__ __forceinline__ bool next(int i, Unit& u) const {
        const int L = i * G + c; if (L >= NU) return false;
        const int it = L / PER, part = L % PER;
        u.a = A + (size_t)it * SA + (size_t)part * PA; u.b = Bt + (size_t)it * SB + (size_t)part * PB; u.pm = it; u.pn = part; u.ro = it * RI + part * RP; u.co = part * CP; u.id = it; return true;
    }
    __device__ __forceinline__ void a_ready(const Unit&) const {}
    __device__ __forceinline__ void done(const Unit&) const {}
};
struct OrdRetOut {
    int G, c; const char* A; const char* Bt;
    __device__ __forceinline__ bool next(int i, Unit& u) const {
        using namespace cfg; const long L = (long)i * G + c; if (L >= 2 * NITEM) return false;
        const int it = (int)L >> 1, part = (int)L & 1, n = it / (RH * NSEG), h = (it / NSEG) % RH, seg = it % NSEG;
        u.a = A + (size_t)it * (256 * 512 * 2); u.b = Bt + ((size_t)it * 512 + part * 256) * (512 * 2); u.pm = it; u.pn = part; u.ro = n * SEQ + seg * 256; u.co = h * RDV + part * 256; u.id = it; return true;
    }
    __device__ __forceinline__ void a_ready(const Unit&) const {}
    __device__ __forceinline__ void done(const Unit&) const {}
};
struct EpiMaskBf16 {
    static constexpr bool PERM = true, AFTER_DRAIN = false;
    bf16_t* O; int ldc;
    __device__ __forceinline__ void operator()(const f32x4 (&acc)[2][2][4][2], const Unit& u, int wr, int wc, int fr, int fq) const {
        int zz; asm volatile("v_mov_b32 %0, 0" : "=v"(zz));
        const int rl0 = wr * 64 + fr + zz, cl0 = wc * 32 + 8 * fq;
#pragma unroll
        for (int ai = 0; ai < 2; ++ai)
#pragma unroll
            for (int m = 0; m < 4; ++m) { const int t = rl0 + ai * HALF + m * 16; bf16_t* rowp = O + (size_t)(u.ro + t) * ldc + u.co + cl0;
#pragma unroll
                for (int bj = 0; bj < 2; ++bj) { const f32x4 v0 = acc[ai][bj][m][0], v1 = acc[ai][bj][m][1]; const int s0 = cl0 + bj * HALF;
                    u32x4 w; w.x = cvt_pk_bf16(s0 + 0 <= t ? v0[0] : 0.f, s0 + 1 <= t ? v0[1] : 0.f); w.y = cvt_pk_bf16(s0 + 2 <= t ? v0[2] : 0.f, s0 + 3 <= t ? v0[3] : 0.f);
                    w.z = cvt_pk_bf16(s0 + 4 <= t ? v1[0] : 0.f, s0 + 5 <= t ? v1[1] : 0.f); w.w = cvt_pk_bf16(s0 + 6 <= t ? v1[2] : 0.f, s0 + 7 <= t ? v1[3] : 0.f);
                    *(u32x4*)(rowp + bj * HALF) = w; } }
    }
};
template <class Epi, class Sched, bool ALIGN_EPI = false, bool SP2 = false>
__device__ __forceinline__ void gemm_phase(PG8_LAS unsigned char* lds, const Gemm g, const Sched& S, const Epi& E, const int wave_s) {
    int tid; asm volatile("v_mbcnt_lo_u32_b32 %0, -1, 0\n\tv_mbcnt_hi_u32_b32 %0, -1, %0" : "=v"(tid)); tid += wave_s * 64;
    const int wid = __builtin_amdgcn_readfirstlane(tid >> 6), lane = tid & 63, wr = wid >> 2, wc = wid & 3, fr = lane & 15, fq = lane >> 4;
    const int K = g.K, nt = K / BK;
    unsigned voffA[2], voffB[2];
#pragma unroll
    for (int i = 0; i < 2; ++i) { int R, C; stage_rc(tid * 16 + i * 8192, R, C); const int Rb = Epi::PERM ? ((R & ~31) + perm32(R & 31)) : R;
        voffA[i] = (unsigned)(R * g.lda + C) * 2u; voffB[i] = (unsigned)(Rb * g.ldb + C) * 2u; }
    const size_t kstep = (size_t)(BK * 2);
    const size_t hstepA = (size_t)HALF * g.lda * 2, hstepB = (size_t)HALF * g.ldb * 2;
    const unsigned ldsw = (unsigned)wid * 1024u;
    const int aoff = lds_byte(wr * 64 + fr, fq * 8), boff = lds_byte(wc * 32 + fr, fq * 8);
#define PG8_SA(b, h) (((b) * 2 + (h)) * HTB)
#define PG8_SB(b, h) ((4 + (b) * 2 + (h)) * HTB)
#define PG8_STAGE(bufoff, gbase, voff) do { _Pragma("unroll") for (int _i = 0; _i < 2; ++_i) \
        __builtin_amdgcn_global_load_lds((const unsigned*)((const char*)(gbase) + (voff)[_i]), (PG8_LAS unsigned*)(lds + (bufoff) + ldsw + _i * 8192), 16, 0, 0); } while (0)
#define PG8_LDA(dst, b, h) do { _Pragma("unroll") for (int m = 0; m < 4; ++m) _Pragma("unroll") for (int k = 0; k < 2; ++k) dst[m][k] = *(const PG8_LAS bf16x8*)(lds + PG8_SA(b, h) + aoff + m * 2048 + k * 1024); } while (0)
#define PG8_LDB(dst, b, h) do { _Pragma("unroll") for (int n = 0; n < 2; ++n) _Pragma("unroll") for (int k = 0; k < 2; ++k) dst[n][k] = *(const PG8_LAS bf16x8*)(lds + PG8_SB(b, h) + boff + n * 2048 + k * 1024); } while (0)
#define PG8_MMA(ai, bj, At, Bt) do { __builtin_amdgcn_s_setprio(1); _Pragma("unroll") for (int m = 0; m < 4; ++m) _Pragma("unroll") for (int n = 0; n < 2; ++n) _Pragma("unroll") for (int k = 0; k < 2; ++k) \
        acc[ai][bj][m][n] = __builtin_amdgcn_mfma_f32_16x16x32_bf16(Bt[n][k], At[m][k], acc[ai][bj][m][n], 0, 0, 0); __builtin_amdgcn_s_setprio(0); } while (0)
#define PG8_WAIT_V(n) asm volatile("s_waitcnt vmcnt(" #n ")" ::: "memory")
#define PG8_WAIT_L(n) asm volatile("s_waitcnt lgkmcnt(" #n ")" ::: "memory")
#define PG8_BAR __builtin_amdgcn_s_barrier()
#define PG8_SCHED __builtin_amdgcn_sched_barrier(0)
    Unit cur, nxt; int ui = 0;
    if (!S.next(0, cur)) return;
    f32x4 acc[2][2][4][2];
#pragma unroll
    for (int a = 0; a < 2; ++a)
#pragma unroll
        for (int b = 0; b < 2; ++b)
#pragma unroll
            for (int m = 0; m < 4; ++m)
#pragma unroll
                for (int n = 0; n < 2; ++n) acc[a][b][m][n] = (f32x4){0.f, 0.f, 0.f, 0.f};
    bf16x8 At[4][2], B0[2][2], B1[2][2];
    const char* cA = cur.a; const char* cB = cur.b;
    S.a_ready(cur);
    if constexpr (SP2) {
        PG8_STAGE(PG8_SB(0, 0), cB, voffB); PG8_STAGE(PG8_SB(0, 1), cB + hstepB, voffB); PG8_STAGE(PG8_SA(0, 0), cA, voffA); PG8_STAGE(PG8_SA(0, 1), cA + hstepA, voffA);
        if (wr == 1) PG8_BAR;
        PG8_WAIT_V(2); PG8_BAR;
        PG8_STAGE(PG8_SB(1, 0), cB + kstep, voffB); PG8_STAGE(PG8_SA(1, 0), cA + kstep, voffA); PG8_STAGE(PG8_SB(1, 1), cB + hstepB + kstep, voffB);
        PG8_WAIT_V(6); PG8_BAR;
    } else {
        PG8_STAGE(PG8_SB(0, 0), cB, voffB); PG8_STAGE(PG8_SA(0, 0), cA, voffA); PG8_STAGE(PG8_SB(0, 1), cB + hstepB, voffB); PG8_STAGE(PG8_SA(0, 1), cA + hstepA, voffA);
        if (wr == 1) PG8_BAR;
        PG8_WAIT_V(4); PG8_BAR;
        PG8_STAGE(PG8_SB(1, 0), cB + kstep, voffB); PG8_STAGE(PG8_SA(1, 0), cA + kstep, voffA); PG8_STAGE(PG8_SB(1, 1), cB + hstepB + kstep, voffB);
        PG8_WAIT_V(6); PG8_BAR;
    }
    for (;;) {
        const bool has_next = S.next(ui + 1, nxt);
        const char* nA = has_next ? nxt.a : cA; const char* nB = has_next ? nxt.b : cB;
        for (int t = 0; t < nt; t += 2) {
            const bool last = (t == nt - 2);
            const char* a1 = cA + (size_t)(t + 1) * kstep;
            const char* a2 = last ? nA : cA + (size_t)(t + 2) * kstep; const char* b2 = last ? nB : cB + (size_t)(t + 2) * kstep;
            const char* a3 = a2 + kstep; const char* b3 = b2 + kstep;
            if (last && has_next) S.a_ready(nxt);
            if constexpr (SP2) {
            PG8_LDB(B0, 0, 0); PG8_LDB(B1, 0, 1); PG8_SCHED; PG8_LDA(At, 0, 0); PG8_STAGE(PG8_SA(1, 1), a1 + hstepA, voffA);
            PG8_WAIT_V(8); PG8_WAIT_L(0); PG8_BAR; PG8_MMA(0, 0, At, B0); PG8_MMA(0, 1, At, B1); PG8_BAR; PG8_SCHED;
            PG8_LDA(At, 0, 1); PG8_STAGE(PG8_SB(0, 0), b2, voffB); PG8_STAGE(PG8_SB(0, 1), b2 + hstepB, voffB); PG8_STAGE(PG8_SA(0, 0), a2, voffA);
            PG8_WAIT_V(8); PG8_WAIT_L(0); PG8_BAR; PG8_MMA(1, 0, At, B0); PG8_MMA(1, 1, At, B1); PG8_BAR; PG8_SCHED;
            PG8_LDB(B0, 1, 0); PG8_LDB(B1, 1, 1); PG8_SCHED; PG8_LDA(At, 1, 0); PG8_STAGE(PG8_SA(0, 1), a2 + hstepA, voffA);
            PG8_WAIT_V(8); PG8_WAIT_L(0); PG8_BAR; PG8_MMA(0, 0, At, B0); PG8_MMA(0, 1, At, B1); PG8_BAR; PG8_SCHED;
            PG8_LDA(At, 1, 1); PG8_STAGE(PG8_SB(1, 0), b3, voffB); PG8_STAGE(PG8_SB(1, 1), b3 + hstepB, voffB); PG8_STAGE(PG8_SA(1, 0), a3, voffA);
            PG8_WAIT_V(8); PG8_WAIT_L(0); PG8_BAR; PG8_MMA(1, 0, At, B0); PG8_MMA(1, 1, At, B1); PG8_BAR; PG8_SCHED;
            } else {
            PG8_LDB(B0, 0, 0); PG8_SCHED; PG8_LDA(At, 0, 0); PG8_STAGE(PG8_SA(1, 1), a1 + hstepA, voffA);
            PG8_WAIT_L(8); PG8_BAR; PG8_WAIT_L(0); PG8_MMA(0, 0, At, B0); PG8_BAR; PG8_SCHED;
            PG8_LDB(B1, 0, 1); PG8_STAGE(PG8_SB(0, 0), b2, voffB);
            PG8_BAR; PG8_WAIT_L(0); PG8_MMA(0, 1, At, B1); PG8_BAR;
            PG8_LDA(At, 0, 1); PG8_STAGE(PG8_SA(0, 0), a2, voffA);
            PG8_BAR; PG8_WAIT_L(0); PG8_MMA(1, 0, At, B0); PG8_BAR; PG8_SCHED;
            PG8_STAGE(PG8_SB(0, 1), b2 + hstepB, voffB);
            PG8_WAIT_V(6); PG8_BAR; PG8_MMA(1, 1, At, B1); PG8_BAR;
            PG8_LDB(B0, 1, 0); PG8_SCHED; PG8_LDA(At, 1, 0); PG8_STAGE(PG8_SA(0, 1), a2 + hstepA, voffA);
            PG8_WAIT_L(8); PG8_BAR; PG8_WAIT_L(0); PG8_MMA(0, 0, At, B0); PG8_BAR; PG8_SCHED;
            PG8_LDB(B1, 1, 1); PG8_STAGE(PG8_SB(1, 0), b3, voffB);
            PG8_BAR; PG8_WAIT_L(0); PG8_MMA(0, 1, At, B1); PG8_BAR;
            PG8_LDA(At, 1, 1); PG8_STAGE(PG8_SA(1, 0), a3, voffA);
            PG8_BAR; PG8_WAIT_L(0); PG8_MMA(1, 0, At, B0); PG8_BAR; PG8_SCHED;
            PG8_STAGE(PG8_SB(1, 1), b3 + hstepB, voffB);
            PG8_WAIT_V(6); PG8_BAR; PG8_MMA(1, 1, At, B1); PG8_BAR;
            }
        }
        if constexpr (ALIGN_EPI) { if (wr == 0) PG8_BAR; }
        if constexpr (!Epi::AFTER_DRAIN) { int l2_; asm volatile("v_mbcnt_lo_u32_b32 %0, -1, 0\n\tv_mbcnt_hi_u32_b32 %0, -1, %0" : "=v"(l2_)); E(acc, cur, wr, wc, l2_ & 15, l2_ >> 4); S.done(cur); }
        if (!has_next) break;
#pragma unroll
        for (int a = 0; a < 2; ++a)
#pragma unroll
            for (int b = 0; b < 2; ++b)
#pragma unroll
                for (int m = 0; m < 4; ++m)
#pragma unroll
                    for (int n = 0; n < 2; ++n) acc[a][b][m][n] = (f32x4){0.f, 0.f, 0.f, 0.f};
        cur = nxt; cA = nA; cB = nB; ++ui;
        if constexpr (ALIGN_EPI) { if (wr == 1) PG8_BAR; }
    }
    PG8_WAIT_V(0);
    if constexpr (!ALIGN_EPI) { if (wr == 0) PG8_BAR; }
    PG8_BAR;
    if constexpr (Epi::AFTER_DRAIN) { E.fused(acc, cur, wr, wc, fr, fq, lds, wid, lane); S.done(cur); }
#undef PG8_SA
#undef PG8_SB
#undef PG8_STAGE
#undef PG8_LDA
#undef PG8_LDB
#undef PG8_MMA
#undef PG8_WAIT_V
#undef PG8_WAIT_L
#undef PG8_BAR
#undef PG8_SCHED
}
}

#define GAS __attribute__((address_space(1)))
#define LAS __attribute__((address_space(3)))
typedef unsigned v4u __attribute__((ext_vector_type(4)));
typedef float f32x4 __attribute__((ext_vector_type(4)));
typedef short bf16x8 __attribute__((ext_vector_type(8)));
typedef GAS unsigned gu32;
typedef GAS unsigned long long gu64;
#define RLX_AGENT __ATOMIC_RELAXED, __HIP_MEMORY_SCOPE_AGENT
#define LDS_WAIT() asm volatile("s_waitcnt lgkmcnt(0)" ::: "memory")
#define VM_WAIT() asm volatile("s_waitcnt vmcnt(0)" ::: "memory")
__device__ __forceinline__ unsigned long long rt() { return __builtin_amdgcn_s_memrealtime(); }
__device__ __forceinline__ unsigned pk2(float lo, float hi) { return f2bf_u(lo) | (f2bf_u(hi) << 16); }

#define XB_TMO      128
#define XB_XCNT(j)  (256  + 64 * (j))
#define XB_XSUB(j)  (1280 + 64 * (j))
#define XB_XGEN(j)  (2304 + 64 * (j))
#define XB_TOP      3328
#define XB_TOPGEN   3392
#define XCD_BAR_WORDS 3456
#define XB_SPIN_CAP (1u << 18)

__device__ __forceinline__ unsigned xb_ld(unsigned* p)              { return __hip_atomic_load(p, __ATOMIC_RELAXED, __HIP_MEMORY_SCOPE_AGENT); }
__device__ __forceinline__ unsigned xb_add(unsigned* p, unsigned v) { return __hip_atomic_fetch_add(p, v, __ATOMIC_RELAXED, __HIP_MEMORY_SCOPE_AGENT); }
__device__ __forceinline__ unsigned xb_xcc_id() { return (unsigned)__builtin_amdgcn_s_getreg((3 << 11) | 20) & 0xFu; }
#define XB_SPIN(cond, bar) do { unsigned _sp = 0; while (cond) { __builtin_amdgcn_s_sleep(1); \
    if ((++_sp & 255u) == 0u) { if (xb_ld(&(bar)[XB_TMO])) break; if (_sp > XB_SPIN_CAP) { atomicAdd(&(bar)[XB_TMO], 1u); break; } } } } while (0)

__device__ __forceinline__ int lane_id() { int l; asm volatile("v_mbcnt_lo_u32_b32 %0, -1, 0\n\tv_mbcnt_hi_u32_b32 %0, -1, %0" : "=v"(l)); return l; }
#define TIDX(ws) ((ws) * 64 + lane_id())
struct XcdBarrier {
    unsigned* bar; unsigned x;
    volatile LAS unsigned* st;
};

__device__ __forceinline__ XcdBarrier xcd_barrier_post(unsigned* bar, volatile LAS unsigned* st, const int wave_s) {
    XcdBarrier b; b.bar = bar; b.x = xb_xcc_id(); b.st = st;
    if (TIDX(wave_s) == 0) (void)xb_add(&bar[XB_XCNT(b.x)], 1u);
    return b;
}
__device__ __forceinline__ void xcd_barrier_complete(unsigned* bar, unsigned x, unsigned& nloc, unsigned& nx) {
    const unsigned G = gridDim.x * gridDim.y * gridDim.z;
    unsigned sum, cnt, mine, sp = 0u;
    for (;;) {
        sum = 0u; cnt = 0u; mine = 0u;
#pragma unroll
        for (unsigned j = 0; j < 16; ++j) { const unsigned c = xb_ld(&bar[XB_XCNT(j)]); sum += c; cnt += (c > 0u) ? 1u : 0u; mine = (j == x) ? c : mine; }
        if (sum == G) break;
        __builtin_amdgcn_s_sleep(1);
        if ((++sp & 255u) == 0u) { if (xb_ld(&bar[XB_TMO])) break; if (sp > XB_SPIN_CAP) { atomicAdd(&bar[XB_TMO], 1u); break; } }
    }
    nloc = mine > 0u ? mine : 1u; nx = cnt > 0u ? cnt : 1u;
}

__device__ __forceinline__ void xcd_barrier(const XcdBarrier& b, const int wave_s) {
    asm volatile("s_waitcnt vmcnt(0)" ::: "memory");
    __syncthreads();
    if (TIDX(wave_s) == 0) {
        unsigned* bar = b.bar;
        __builtin_amdgcn_s_waitcnt(0);
        unsigned nloc = b.st[0], nx = b.st[1];
        if (nloc == 0u) { xcd_barrier_complete(bar, b.x, nloc, nx); b.st[0] = nloc; b.st[1] = nx; }
        const unsigned old = xb_add(&bar[XB_XSUB(b.x)], 1u);
        const unsigned gen = old / nloc;
        if (old + 1u == (gen + 1u) * nloc) {
            __builtin_amdgcn_fence(__ATOMIC_RELEASE, "agent");
            asm volatile("s_waitcnt vmcnt(0)" ::: "memory");
            const unsigned og = xb_add(&bar[XB_TOP], 1u);
            const unsigned tg = og / nx;
            if (og + 1u == (tg + 1u) * nx) xb_add(&bar[XB_TOPGEN], 1u);
            else XB_SPIN(xb_ld(&bar[XB_TOPGEN]) == tg, bar);
            __builtin_amdgcn_fence(__ATOMIC_ACQUIRE, "agent");
            xb_add(&bar[XB_XGEN(b.x)], 1u);
            asm volatile("s_waitcnt vmcnt(0)" ::: "memory");
        } else {
            XB_SPIN(xb_ld(&bar[XB_XGEN(b.x)]) == gen, bar);
            __builtin_amdgcn_fence(__ATOMIC_ACQUIRE, "agent");
            asm volatile("s_waitcnt vmcnt(0)" ::: "memory");
        }
    }
    __syncthreads();
}

constexpr int NWAVES = 8, NT = NWAVES * 64;
#ifndef MK_ONE_LAUNCH
#define MK_ONE_LAUNCH 1
#endif
constexpr int PH_PRO = 0, PH_ADA = 1, PH_MOD0 = 2, PH_L0 = 3, PH_PER_LAYER = 13, NPH = PH_L0 + 2 * PH_PER_LAYER;
enum Slot { S_G1A = 0, S_G2A, S_LNA, S_MIN, S_MA, S_MB, S_MC, S_MD, S_MOUT, S_LNM, S_G1B, S_G2B, S_LNB };
namespace wsm {
using namespace cfg;
constexpr size_t al(size_t x) { return (x + 4095) & ~(size_t)4095; }
constexpr size_t CTL = 0, CTL_BYTES = 1u << 20;
constexpr size_t WFI = al(CTL + CTL_BYTES);
constexpr size_t WFO = al(WFI + (size_t)4 * NFF * D * 2);
constexpr size_t WRI = al(WFO + (size_t)4 * D * FF * 2);
constexpr size_t WRO = al(WRI + (size_t)NRET * D * 2);
constexpr size_t WAI = al(WRO + (size_t)D * VW * 2);
constexpr size_t WAO = al(WAI + (size_t)NATT * D * 2);
constexpr size_t WADA = al(WAO + (size_t)D * AO * 2);
constexpr size_t SC = al(WADA + (size_t)18 * D * D * 2);
constexpr size_t ADA = al(SC + (size_t)SCR * D * 2);
constexpr size_t X = al(ADA + (size_t)SCR * ADA_LD * 4);
constexpr size_t Y = al(X + (size_t)M * D * 4);
constexpr size_t XN = al(Y + (size_t)M * D * 4);
constexpr size_t H = al(XN + (size_t)M * D * 2);
constexpr size_t QKV = al(H + (size_t)M * FF * 2);
constexpr size_t AOB = al(QKV + (size_t)M * NRET * 2);
constexpr size_t OB = al(AOB + (size_t)M * VW * 2);
constexpr size_t U = al(OB + (size_t)M * AO * 2);
constexpr size_t SIN = al(U + (size_t)NITEM * RDK * RDV * 4);
constexpr size_t PS = al(SIN + (size_t)NITEM * RDK * RDV * 4);
constexpr size_t ORET = al(PS + (size_t)NITEM * RC * RC * 4);
constexpr size_t OG = al(ORET + (size_t)M * VW * 4);
constexpr size_t LSE = al(OG + (size_t)3 * M * AO * 4);
constexpr size_t A2 = al(LSE + (size_t)3 * M * AH * 4);
constexpr size_t B2 = al(A2 + (size_t)NITEM * 256 * 512 * 2);
constexpr size_t KB = al(B2 + (size_t)NITEM * 512 * 512 * 2);
constexpr size_t KT = al(KB + (size_t)NITEM * 256 * 256 * 2);
constexpr size_t UT = al(KT + (size_t)NITEM * 256 * 256 * 2);
constexpr size_t GB = al(UT + (size_t)NITEM * 512 * 256 * 4);
constexpr size_t QS = al(GB + (size_t)M * VW * 2);
constexpr size_t END = al(QS + (size_t)MS * (2 * QKW + VW) * 2);
static_assert(RC == 256 && RDK == 256 && RDV == 512 && SEQ % 256 == 0 && MS % 256 == 0, "MFMA retention geometry");
static_assert(NRET >= NATT, "QKV buffer is sized by the retention projection");
}
constexpr int CW_TMO = 0, CW_CODE = 1, CW_BAR = 4096;
constexpr int RING_OFF = 0, RING_BYTES = 131072;
constexpr int LDSCTL_OFF = RING_BYTES, MISC_OFF = LDSCTL_OFF + 320;
constexpr int LDS_BYTES = 147456;

struct Args { Ptrs p; int ph_lo, ph_hi; };

__device__ __forceinline__ const Args* kargs() { auto k = __builtin_amdgcn_kernarg_segment_ptr(); asm volatile("" : "+s"(k)); return (const Args*)k; }
#define GRID_ITEMS(total, call) do { const long _tot = (long)(total); for (long _i = (long)blockIdx.x * NT + tid; _i < _tot; _i += (long)gridDim.x * NT) { call; } } while (0)

__device__ __forceinline__ void p0_transpose_item(const float* W, int K, int N, bf16* WT, int ffn, int row_off, LAS float* scr, int item, int lane) {
    const int nblk = N / 32, kb = item / nblk, nb = item % nblk, k0 = 64 * kb, n0 = 32 * nb;
    const int dst0 = ffn ? ffn_dst_of_src(n0) : row_off + n0;
#pragma unroll 8
    for (int i = 0; i < 32; ++i) { const int kk = 2 * i + (lane >> 5); scr[kk * 33 + (lane & 31)] = W[(size_t)(k0 + kk) * N + n0 + (lane & 31)]; }
    LDS_WAIT(); asm volatile("" ::: "memory");
    const int c = lane & 7;
#pragma unroll
    for (int j = 0; j < 4; ++j) { const int n = (lane >> 3) + 8 * j; const LAS float* s = scr + (8 * c) * 33 + n;
        v4u o; o.x = pk2(s[0 * 33], s[1 * 33]); o.y = pk2(s[2 * 33], s[3 * 33]); o.z = pk2(s[4 * 33], s[5 * 33]); o.w = pk2(s[6 * 33], s[7 * 33]);
        *(GAS v4u*)(WT + (size_t)(dst0 + n) * K + k0 + 8 * c) = o; }
    LDS_WAIT(); asm volatile("" ::: "memory");
}
__device__ __forceinline__ void p0_prologue(const Ptrs& p, LAS unsigned char* lds, int tid, int wave, int lane) {
    using namespace cfg;
    LAS float* scr = (LAS float*)(lds + RING_OFF + wave * 16384);
    const int gw = blockIdx.x * NWAVES + wave, NGW = gridDim.x * NWAVES;
    constexpr int I_FI = (D / 64) * (NFF / 32), I_FO = (FF / 64) * (D / 32), I_RI = (D / 64) * (NRET / 32), I_RO = (VW / 64) * (D / 32), I_AI = (D / 64) * (NATT / 32), I_AO = (AO / 64) * (D / 32), I_AD = (D / 64) * (9 * D / 32);
    constexpr int NITEMS = 4 * I_FI + 4 * I_FO + I_RI + I_RO + I_AI + I_AO + 2 * I_AD;
    for (int it = gw; it < NITEMS; it += NGW) {
        int r = it;
        if (r < 4 * I_FI) { const int w = r / I_FI; p0_transpose_item(p.w_ffn_in + (size_t)w * D * NFF, D, NFF, p.wfi_t + (size_t)w * NFF * D, 1, 0, scr, r % I_FI, lane); continue; } r -= 4 * I_FI;
        if (r < 4 * I_FO) { const int w = r / I_FO; p0_transpose_item(p.w_ffn_out + (size_t)w * FF * D, FF, D, p.wfo_t + (size_t)w * D * FF, 0, 0, scr, r % I_FO, lane); continue; } r -= 4 * I_FO;
        if (r < I_RI) { p0_transpose_item(p.w_ret_in, D, NRET, p.wri_t, 0, 0, scr, r, lane); continue; } r -= I_RI;
        if (r < I_RO) { p0_transpose_item(p.w_ret_out, VW, D, p.wro_t, 0, 0, scr, r, lane); continue; } r -= I_RO;
        if (r < I_AI) { p0_transpose_item(p.w_att_in, D, NATT, p.wai_t, 0, 0, scr, r, lane); continue; } r -= I_AI;
        if (r < I_AO) { p0_transpose_item(p.w_att_out, AO, D, p.wao_t, 0, 0, scr, r, lane); continue; } r -= I_AO;
        { const int w = r / I_AD; p0_transpose_item(p.w_ada + (size_t)w * D * 9 * D, D, 9 * D, p.wada_t, 0, w * 9 * D, scr, r % I_AD, lane); }
    }
    GRID_ITEMS((long)SCR * D, it_silu_c(p, _i));
}

__device__ __forceinline__ float wave_sum(float v) {
#pragma unroll
    for (int o = 1; o < 64; o <<= 1) v += __shfl_xor(v, o);
    return v;
}
__device__ __forceinline__ void ln_rows_phase(const Ptrs& p, int layer, int j, float coef, int nl, int nj, int wave, int lane) {
    using namespace cfg; static_assert(D == 1024, "ln_rows_phase: 64 lanes x 4 floats x 4");
    const int gw = blockIdx.x * NWAVES + wave, NGW = gridDim.x * NWAVES;
    const f32x4* lg = (const f32x4*)(p.ln_g + (size_t)(layer * 3 + j) * D) + lane; const f32x4* lb = (const f32x4*)(p.ln_b + (size_t)(layer * 3 + j) * D) + lane;
    f32x4 g4[4], b4[4];
#pragma unroll
    for (int jj = 0; jj < 4; ++jj) { g4[jj] = lg[64 * jj]; b4[jj] = lb[64 * jj]; }
    for (int m = gw; m < M; m += NGW) {
        const int s = seq_of_row(m);
        const f32x4* xr = (const f32x4*)(p.X + (size_t)m * D) + lane; const f32x4* yr = (const f32x4*)(p.Y + (size_t)m * D) + lane; const f32x4* gt = (const f32x4*)ada_vec(p, s, layer, j, 2) + lane;
        f32x4 z[4]; float sum = 0.f;
#pragma unroll
        for (int jj = 0; jj < 4; ++jj) { const f32x4 x = xr[64 * jj], y = yr[64 * jj], g = gt[64 * jj]; z[jj] = ALPHA * x + coef * (1.0f + g) * y; sum += (z[jj].x + z[jj].y) + (z[jj].z + z[jj].w); }
        const float mu = wave_sum(sum) * (1.0f / D); float sq = 0.f;
#pragma unroll
        for (int jj = 0; jj < 4; ++jj) { z[jj] = z[jj] - mu; sq += (z[jj].x * z[jj].x + z[jj].y * z[jj].y) + (z[jj].z * z[jj].z + z[jj].w * z[jj].w); }
        const float rstd = 1.0f / sqrtf(wave_sum(sq) * (1.0f / D) + LN_EPS);
        if (nj >= 0) {
            const f32x4* sh = (const f32x4*)ada_vec(p, s, nl, nj, 0) + lane; const f32x4* sc = (const f32x4*)ada_vec(p, s, nl, nj, 1) + lane;
            f32x4* xo = (f32x4*)(p.X + (size_t)m * D) + lane; unsigned long long* xn = (unsigned long long*)(p.XN + (size_t)m * D) + lane;
#pragma unroll
            for (int jj = 0; jj < 4; ++jj) { const f32x4 v = z[jj] * rstd * g4[jj] + b4[jj]; xo[64 * jj] = v; const f32x4 u = v * (1.0f + sc[64 * jj]) + sh[64 * jj];
                xn[64 * jj] = (unsigned long long)pk2(u.x, u.y) | ((unsigned long long)pk2(u.z, u.w) << 32); }
        } else {
            f32x4* o = (f32x4*)(p.out + (size_t)m * D) + lane;
#pragma unroll
            for (int jj = 0; jj < 4; ++jj) o[64 * jj] = z[jj] * rstd * g4[jj] + b4[jj];
        }
    }
}
__device__ __forceinline__ void ret_gate_phase(const Ptrs& p, const bf16* gbase, int gld, int wave, int lane) {
    using namespace cfg; static_assert(RDV == 512, "ret_gate_phase: 64 lanes x 8");
    const int gw = blockIdx.x * NWAVES + wave, NGW = gridDim.x * NWAVES;
    for (int it = gw; it < M * RH; it += NGW) {
        const size_t m = (size_t)(it / RH); const int h = it % RH;
        const f32x4* o = (const f32x4*)(p.ORET + m * VW + h * RDV) + 2 * lane; const f32x4 o0 = o[0], o1 = o[1];
        const v4u gq = *((const v4u*)(gbase + m * gld + h * RDV) + lane);
        const float mu = wave_sum((o0.x + o0.y) + (o0.z + o0.w) + (o1.x + o1.y) + (o1.z + o1.w)) * (1.0f / RDV);
        const f32x4 d0 = o0 - mu, d1 = o1 - mu;
        const float rstd = 1.0f / sqrtf(wave_sum((d0.x * d0.x + d0.y * d0.y) + (d0.z * d0.z + d0.w * d0.w) + (d1.x * d1.x + d1.y * d1.y) + (d1.z * d1.z + d1.w * d1.w)) * (1.0f / RDV) + LN_EPS);
        const f32x4* gg = (const f32x4*)(p.ret_gn_g + h * RDV) + 2 * lane; const f32x4* gb = (const f32x4*)(p.ret_gn_b + h * RDV) + 2 * lane;
        const f32x4 n0 = d0 * rstd * gg[0] + gb[0], n1 = d1 * rstd * gg[1] + gb[1];
        v4u w;
        w.x = pk2(silu_f(bf2f((bf16)(gq.x & 0xffffu))) * n0.x, silu_f(bf2f((bf16)(gq.x >> 16))) * n0.y); w.y = pk2(silu_f(bf2f((bf16)(gq.y & 0xffffu))) * n0.z, silu_f(bf2f((bf16)(gq.y >> 16))) * n0.w);
        w.z = pk2(silu_f(bf2f((bf16)(gq.z & 0xffffu))) * n1.x, silu_f(bf2f((bf16)(gq.z >> 16))) * n1.y); w.w = pk2(silu_f(bf2f((bf16)(gq.w & 0xffffu))) * n1.z, silu_f(bf2f((bf16)(gq.w >> 16))) * n1.w);
        *((v4u*)(p.AOB + m * VW + h * RDV) + lane) = w;
    }
}
__device__ __forceinline__ void rets_phase(const Ptrs& p, const bf16* qkv, int ld, LAS unsigned char* lds, int tid, int wave, int lane) {
    using namespace cfg; static_assert(DS == 4 && RDK == 256 && RDV == 512 && NT == 512, "rets_phase geometry");
    LAS float* qs = (LAS float*)lds;
    LAS float* kd = qs + 4 * RDK;
    LAS float* qk = kd + 4 * RDK;
    LAS float* op = qk + 16;
    const float ks = 1.0f / 16.0f;
    for (int it = blockIdx.x; it < DB * RH; it += gridDim.x) {
        const int n = it / RH, h = it % RH; const float lgam = ret_log_gamma(h);
        const bf16* rows = qkv + ((size_t)MP + (size_t)n * DS) * ld;
        __syncthreads();
        for (int i = tid; i < 4 * RDK; i += NT) { const int t = i >> 8, d = i & 255;
            qs[d * 4 + t] = bf2f(rows[(size_t)t * ld + h * RDK + d]) * expf((float)(t + 1) * lgam);
            kd[d * 4 + t] = bf2f(rows[(size_t)t * ld + QKW + h * RDK + d]) * ks * expf((float)(3 - t) * lgam); }
#pragma unroll
        for (int pi = 0; pi < 2; ++pi) { const int pr = 2 * wave + pi, t = pr >> 2, s = pr & 3; float a = 0.f;
#pragma unroll
            for (int c = 0; c < 4; ++c) { const int d = lane + 64 * c; a += bf2f(rows[(size_t)t * ld + h * RDK + d]) * bf2f(rows[(size_t)s * ld + QKW + h * RDK + d]); }
            a = wave_sum(a); if (lane == 0) qk[pr] = s <= t ? a * ks * expf((float)(t - s) * lgam) : 0.f; }
        const int ec = tid & 127, dr = tid >> 7;
        f32x4 vv[4];
#pragma unroll
        for (int s = 0; s < 4; ++s) { const unsigned long long w = *((const unsigned long long*)(rows + (size_t)s * ld + 2 * QKW + h * RDV) + ec);
            vv[s] = (f32x4){bf2f((bf16)(w & 0xffffu)), bf2f((bf16)((w >> 16) & 0xffffu)), bf2f((bf16)((w >> 32) & 0xffffu)), bf2f((bf16)(w >> 48))}; }
        LDS_WAIT(); __syncthreads();
        const float g4 = expf(4.0f * lgam);
        const f32x4* S0 = (const f32x4*)(p.state_ret + (size_t)it * (RDK * RDV)) + ec; f32x4* S1 = (f32x4*)(p.out + O_SRS + (size_t)it * (RDK * RDV)) + ec;
        f32x4 oa[4] = {(f32x4){0.f, 0.f, 0.f, 0.f}, (f32x4){0.f, 0.f, 0.f, 0.f}, (f32x4){0.f, 0.f, 0.f, 0.f}, (f32x4){0.f, 0.f, 0.f, 0.f}};
#pragma unroll 1
        for (int d0 = dr; d0 < RDK; d0 += 32) {
            f32x4 sv[8];
#pragma unroll
            for (int u = 0; u < 8; ++u) sv[u] = __builtin_nontemporal_load(S0 + (size_t)(d0 + 4 * u) * (RDV / 4));
#pragma unroll
            for (int u = 0; u < 8; ++u) { const int d = d0 + 4 * u;
                const f32x4 k4 = *(const LAS f32x4*)(kd + d * 4), q4 = *(const LAS f32x4*)(qs + d * 4);
                const f32x4 sn = g4 * sv[u] + k4.x * vv[0] + k4.y * vv[1] + k4.z * vv[2] + k4.w * vv[3];
                __builtin_nontemporal_store(sn, S1 + (size_t)d * (RDV / 4));
                oa[0] += q4.x * sv[u]; oa[1] += q4.y * sv[u]; oa[2] += q4.z * sv[u]; oa[3] += q4.w * sv[u]; }
        }
#pragma unroll
        for (int t = 0; t < 4; ++t) *((LAS f32x4*)(op + (dr * 4 + t) * RDV) + ec) = oa[t];
        LDS_WAIT(); __syncthreads();
        { const int t = tid >> 7;
            f32x4 o = *((LAS f32x4*)(op + (0 * 4 + t) * RDV) + ec) + *((LAS f32x4*)(op + (1 * 4 + t) * RDV) + ec) + *((LAS f32x4*)(op + (2 * 4 + t) * RDV) + ec) + *((LAS f32x4*)(op + (3 * 4 + t) * RDV) + ec);
#pragma unroll
            for (int s = 0; s < 4; ++s) o += qk[t * 4 + s] * vv[s];
            *((f32x4*)(p.ORET + ((size_t)MP + (size_t)n * DS + t) * VW + h * RDV) + ec) = o; }
    }
    __syncthreads();
}
__device__ __forceinline__ void ret_scan_phase(const Ptrs& p, int tid) {
    using namespace cfg;
    for (int idx = blockIdx.x * NT + tid; idx < BATCH * RH * 512 * 64; idx += gridDim.x * NT) {
        const int d4 = idx & 63, e = (idx >> 6) & 511, nh = idx >> 15, h = nh % RH; const float cd = expf((float)RC * ret_log_gamma(h));
        f32x4 S = (f32x4){0.f, 0.f, 0.f, 0.f};
        const f32x4* u = (const f32x4*)(p.UT + ((size_t)nh * NSEG * 512 + e) * 256) + d4; unsigned long long* o = (unsigned long long*)(p.B2 + ((size_t)nh * NSEG * 512 + e) * 512 + 256) + d4;
#pragma unroll 8
        for (int seg = 0; seg < NSEG; ++seg) { const f32x4 uv = u[(size_t)seg * (512 * 256 / 4)];
            o[(size_t)seg * (512 * 512 / 4)] = (unsigned long long)pk2(S.x, S.y) | ((unsigned long long)pk2(S.z, S.w) << 32);
            S = cd * (S + uv); }
        float* fo = p.out + O_SRP + ((size_t)nh * RDK + 4 * d4) * RDV + e;
        fo[0] = S.x; fo[RDV] = S.y; fo[2 * RDV] = S.z; fo[3 * RDV] = S.w;
    }
}
namespace att {
using bf16x8 = __attribute__((ext_vector_type(8))) short;
using s16x4 = __attribute__((ext_vector_type(4))) short;
using f32x16 = __attribute__((ext_vector_type(16))) float;
typedef short v4i16_t __attribute__((ext_vector_type(4)));
typedef float f32x2_t __attribute__((ext_vector_type(2))); typedef __bf16 bf16x2_t __attribute__((ext_vector_type(2)));
constexpr int KOFF = 0, VOFF = 6 * 8192, WSOFF = 12 * 8192, LDS_NEED = WSOFF + 8 * 256;
__device__ __forceinline__ int crow(int r, int hi) { return (r & 3) + 8 * (r >> 2) + 4 * hi; }
__device__ __forceinline__ void glds16(const void* gsrc, unsigned lds_dst) { unsigned keep;
    asm volatile("s_mov_b32 %0, m0\n\ts_mov_b32 m0, %2\n\ts_nop 0\n\tglobal_load_lds_dwordx4 %1, off\n\ts_mov_b32 m0, %0" : "=&s"(keep) : "v"(gsrc), "s"(lds_dst) : "memory"); }
__device__ __forceinline__ unsigned cvtpk(float lo, float hi) { f32x2_t v = {lo, hi}; bf16x2_t b = __builtin_convertvector(v, bf16x2_t); return __builtin_bit_cast(unsigned, b); }
__device__ __forceinline__ void pv(f32x16* o, int vb, bf16x8 pa0, bf16x8 pa1, bf16x8 pa2, bf16x8 pa3) {
#pragma unroll
    for (int d0 = 0; d0 < 2; ++d0) { s16x4 lo[4], hi[4];
#pragma unroll
        for (int ks = 0; ks < 4; ++ks) {
            asm volatile("ds_read_b64_tr_b16 %0,%1 offset:%c2" : "=&v"(lo[ks]) : "v"(vb), "i"(d0 * 4096 + ks * 1024) : "memory");
            asm volatile("ds_read_b64_tr_b16 %0,%1 offset:%c2" : "=&v"(hi[ks]) : "v"(vb), "i"(d0 * 4096 + ks * 1024 + 512) : "memory"); }
        asm volatile("s_waitcnt lgkmcnt(0)" ::: "memory"); __builtin_amdgcn_sched_barrier(0);
#define ATT_PK(k) (bf16x8){lo[k][0], lo[k][1], lo[k][2], lo[k][3], hi[k][0], hi[k][1], hi[k][2], hi[k][3]}
        o[d0] = __builtin_amdgcn_mfma_f32_32x32x16_bf16(pa0, ATT_PK(0), o[d0], 0, 0, 0);
        o[d0] = __builtin_amdgcn_mfma_f32_32x32x16_bf16(pa1, ATT_PK(1), o[d0], 0, 0, 0);
        o[d0] = __builtin_amdgcn_mfma_f32_32x32x16_bf16(pa2, ATT_PK(2), o[d0], 0, 0, 0);
        o[d0] = __builtin_amdgcn_mfma_f32_32x32x16_bf16(pa3, ATT_PK(3), o[d0], 0, 0, 0);
#undef ATT_PK
    }
}
__device__ __forceinline__ void prompt_unit(const bf16* QKV, float* OG, float* LSE, int n, int g, int head, int cls, int qb, LAS unsigned char* lds, int wid, int lane) {
    using namespace cfg;
    const int r32 = lane & 31, hi = lane >> 5, dl = dil(g), l0 = qb * 256, kbase = l0 - 128;
    const size_t rs = (size_t)dl * NATT;
    const bf16* Qb = QKV + ((size_t)n * SEQ + cls) * NATT + g * AO + head * AD; const bf16* Kb = Qb + 3 * AO; const bf16* Vb = Qb + 6 * AO;
    const unsigned lds0 = (unsigned)(uintptr_t)lds;
#pragma unroll 1
    for (int T = 0; T < 6; ++T) {
        int key = kbase + 64 * T + lane; key = key < 0 ? 0 : key;
        glds16(Kb + (size_t)key * rs + wid * 8, (unsigned)__builtin_amdgcn_readfirstlane(lds0 + KOFF + T * 8192 + wid * 1024));
        int vr = kbase + 64 * T + 16 * (wid & 3) + (lane >> 2); vr = vr < 0 ? 0 : vr;
        glds16(Vb + (size_t)vr * rs + (wid >> 2) * 32 + (lane & 3) * 8, (unsigned)__builtin_amdgcn_readfirstlane(lds0 + VOFF + T * 8192 + wid * 1024));
    }
    const int ql = l0 + 32 * wid + r32;
    bf16x8 qr[4];
#pragma unroll
    for (int d0 = 0; d0 < 4; ++d0) qr[d0] = *reinterpret_cast<const bf16x8*>(Qb + (size_t)ql * rs + d0 * 16 + hi * 8);
    asm volatile("s_waitcnt vmcnt(0)\n\ts_barrier" ::: "memory");
    const int T0 = wid >> 1;
    f32x16 p[3][2];
#pragma unroll
    for (int j = 0; j < 3; ++j) {
        const LAS unsigned char* kb = lds + KOFF + (T0 + j) * 8192 + hi * 1024 + r32 * 16;
        f32x16 a0 = {}, a1 = {};
#pragma unroll
        for (int d0 = 0; d0 < 4; ++d0) { const bf16x8 b0 = *(const LAS bf16x8*)(kb + d0 * 2048), b1 = *(const LAS bf16x8*)(kb + d0 * 2048 + 512);
            a0 = __builtin_amdgcn_mfma_f32_32x32x16_bf16(b0, qr[d0], a0, 0, 0, 0); a1 = __builtin_amdgcn_mfma_f32_32x32x16_bf16(b1, qr[d0], a1, 0, 0, 0); }
        p[j][0] = a0; p[j][1] = a1;
    }
    const float c2 = 0.125f * 1.4426950408889634f, sl2 = alibi_slope(g, head) * (float)dl * 1.4426950408889634f;
    int zz; asm volatile("v_mov_b32 %0, 0" : "=v"(zz));
    const int dmax = (ql < 128 ? ql : 128) + zz;
    float mx = -INFINITY;
#pragma unroll
    for (int j = 0; j < 3; ++j)
#pragma unroll
        for (int kb2 = 0; kb2 < 2; ++kb2) { const int dbase = 32 * (wid & 1) + r32 + 128 - 64 * j - 32 * kb2 - 4 * hi + zz;
#pragma unroll
            for (int i = 0; i < 16; ++i) { const int dist = dbase - ((i & 3) + 8 * (i >> 2)); const float s = p[j][kb2][i] * c2 - sl2 * (float)dist;
                const float sm = ((unsigned)dist <= (unsigned)dmax) ? s : -INFINITY; p[j][kb2][i] = sm; mx = fmaxf(mx, sm); } }
    { auto rr = __builtin_amdgcn_permlane32_swap(__float_as_uint(mx), __float_as_uint(mx), false, false); mx = fmaxf(__uint_as_float(rr[0]), __uint_as_float(rr[1])); }
    float lsum = 0.f;
#pragma unroll
    for (int j = 0; j < 3; ++j)
#pragma unroll
        for (int kb2 = 0; kb2 < 2; ++kb2)
#pragma unroll
            for (int i = 0; i < 16; ++i) { const float e = __builtin_amdgcn_exp2f(p[j][kb2][i] - mx); p[j][kb2][i] = e; lsum += e; }
    { auto rr = __builtin_amdgcn_permlane32_swap(__float_as_uint(lsum), __float_as_uint(lsum), false, false); lsum = __uint_as_float(rr[0]) + __uint_as_float(rr[1]); }
    f32x16 o[2]; o[0] = f32x16{}; o[1] = f32x16{};
    const int vb0 = (int)(lds0 + VOFF) + ((lane >> 4) & 1) * 32 + (lane & 3) * 8 + (4 * hi + ((lane & 15) >> 2)) * 64;
#pragma unroll
    for (int j = 0; j < 3; ++j) {
        typedef unsigned u32x4_t __attribute__((ext_vector_type(4)));
        const f32x16 P0 = p[j][0], P1 = p[j][1];
        const u32x4_t w0 = {cvtpk(P0[0], P0[1]), cvtpk(P0[2], P0[3]), cvtpk(P0[4], P0[5]), cvtpk(P0[6], P0[7])}, w1 = {cvtpk(P0[8], P0[9]), cvtpk(P0[10], P0[11]), cvtpk(P0[12], P0[13]), cvtpk(P0[14], P0[15])};
        const u32x4_t w2 = {cvtpk(P1[0], P1[1]), cvtpk(P1[2], P1[3]), cvtpk(P1[4], P1[5]), cvtpk(P1[6], P1[7])}, w3 = {cvtpk(P1[8], P1[9]), cvtpk(P1[10], P1[11]), cvtpk(P1[12], P1[13]), cvtpk(P1[14], P1[15])};
        pv(o, vb0 + (T0 + j) * 8192, __builtin_bit_cast(bf16x8, w0), __builtin_bit_cast(bf16x8, w1), __builtin_bit_cast(bf16x8, w2), __builtin_bit_cast(bf16x8, w3));
    }
    LAS float* wsf = (LAS float*)(lds + WSOFF) + wid * 64;
    if (hi == 0) wsf[r32] = lsum;
    asm volatile("s_waitcnt lgkmcnt(0)" ::: "memory");
    const size_t mrow0 = (size_t)n * SEQ + (size_t)(l0 + 32 * wid) * dl + cls;
    if (hi == 0) LSE[((size_t)g * M + mrow0 + (size_t)r32 * dl) * AH + head] = (mx + __builtin_amdgcn_logf(lsum)) * 0.69314718055994531f;
    float* ob = OG + ((size_t)g * M + mrow0) * AO + head * AD + r32;
#pragma unroll
    for (int r = 0; r < 16; ++r) { const int q = crow(r, hi); const float rl = __builtin_amdgcn_rcpf(wsf[q]); float* orow = ob + (size_t)q * dl * AO;
        orow[0] = o[0][r] * rl; orow[32] = o[1][r] * rl; }
    asm volatile("s_waitcnt lgkmcnt(0)\n\ts_barrier" ::: "memory");
}
__device__ __forceinline__ void prompt_phase(const bf16* QKV, float* OG, float* LSE, LAS unsigned char* lds, int wid, int lane) {
    using namespace cfg; static_assert(SEQ % (256 * CFG_DIL2) == 0 && AD == 64 && AH == 8 && CFG_W0 / CFG_DIL0 == 128 && CFG_W1 / CFG_DIL1 == 128 && CFG_W2 / CFG_DIL2 == 128, "prompt attention geometry");
    constexpr int BPS = SEQ / 256, NU = BATCH * NG * AH * BPS;
    for (int u = blockIdx.x; u < NU; u += gridDim.x) {
        const int bc = u % BPS, head = (u / BPS) % AH, g = (u / (BPS * AH)) % NG, n = u / (BPS * AH * NG);
        const int nqb = BPS / dil(g), cls = bc / nqb, qb = bc % nqb;
        prompt_unit(QKV, OG, LSE, n, g, head, cls, qb, lds, wid, lane);
    }
}
}
#define PHASE_TID() int tid = TIDX(wave_s); asm volatile("" : "+v"(tid)); const int lane = tid & 63, wave = wave_s; (void)lane; (void)wave
#define IN(k) (lo <= (k) && (k) < hi)
#define SEAM(k) do { if (MK_ONE_LAUNCH && IN((k) + 1)) xcd_barrier(bar, wave_s); } while (0)
template <int L> __device__ __forceinline__ void layer_phases(LAS unsigned char* lds, const XcdBarrier& bar, const int lo, const int hi, const int G, const int wave_s) {
    using namespace cfg;
    constexpr int base = PH_L0 + PH_PER_LAYER * L;

        if (IN(base + S_G1A)) { const Ptrs p = kargs()->p;
            pg8::Gemm g{D, D, D}; pg8::StaticOrder S; S.init(p.XN, D, p.wfi_t + (size_t)(L * 2 + 0) * NFF * D, D, M, NFF, G, (int)blockIdx.x);
            pg8::EpiSwiglu E{p.H, FF};
            pg8::gemm_phase<pg8::EpiSwiglu, pg8::StaticOrder, true, true>(lds + RING_OFF, g, S, E, wave_s);
            SEAM(base + S_G1A);
        }
        if (IN(base + S_G2A)) { const Ptrs p = kargs()->p;
            pg8::Gemm g{FF, FF, FF}; pg8::StaticOrder S; S.init(p.H, FF, p.wfo_t + (size_t)(L * 2 + 0) * D * FF, FF, M, D, G, (int)blockIdx.x);
            pg8::EpiF32 E{p.Y, D, nullptr};
            pg8::gemm_phase<pg8::EpiF32, pg8::StaticOrder, true, true>(lds + RING_OFF, g, S, E, wave_s);
            SEAM(base + S_G2A);
        }
        if (IN(base + S_LNA)) { const Ptrs p = kargs()->p; PHASE_TID(); ln_rows_phase(p, L, 0, 0.5f, L, 1, wave, lane); SEAM(base + S_LNA); }
        if constexpr (L == 0) {
            if (IN(base + S_MIN)) {
                { const Ptrs p = kargs()->p; const pg8::RetBufs rb{p.A2, p.B2, p.KB, p.KT, p.GB, p.QS}; pg8::Gemm g{D, D, D}; pg8::OrdRetIn1 S{G, (int)blockIdx.x, (const char*)p.XN, (const char*)p.wri_t}; pg8::EpiRetIn1 E{rb};
                  pg8::gemm_phase<pg8::EpiRetIn1, pg8::OrdRetIn1, true, true>(lds + RING_OFF, g, S, E, wave_s); }
                { const Ptrs p = kargs()->p; const pg8::RetBufs rb{p.A2, p.B2, p.KB, p.KT, p.GB, p.QS}; pg8::Gemm g{D, D, D}; pg8::OrdRetIn2 S{G, (int)blockIdx.x, (const char*)(p.wri_t + (size_t)QKW * D), (const char*)p.XN}; pg8::EpiRetIn2 E{rb};
                  pg8::gemm_phase<pg8::EpiRetIn2, pg8::OrdRetIn2, true, true>(lds + RING_OFF, g, S, E, wave_s); }
                SEAM(base + S_MIN);
            }
            if (IN(base + S_MA)) {
                { const Ptrs p = kargs()->p; pg8::Gemm g{512, 256, 256};
                  typedef pg8::OrdBatch<2 * NITEM, 2, (size_t)512 * 512 * 2, (size_t)256 * 512 * 2, (size_t)256 * 256 * 2, 0, 512, 256, 0> Ord; Ord S{G, (int)blockIdx.x, (const char*)p.B2, (const char*)p.KT};
                  pg8::EpiF32 E{p.UT, 256, nullptr};
                  pg8::gemm_phase<pg8::EpiF32, Ord, true, true>(lds + RING_OFF, g, S, E, wave_s); }
                { const Ptrs p = kargs()->p; pg8::Gemm g{512, 256, 256};
                  typedef pg8::OrdBatch<NITEM, 1, (size_t)256 * 512 * 2, 0, (size_t)256 * 256 * 2, 0, 256, 0, 0> Ord; Ord S{G, (int)blockIdx.x, (const char*)(p.A2 + 256), (const char*)p.KB};
                  pg8::EpiMaskBf16 E{p.A2, 512};
                  pg8::gemm_phase<pg8::EpiMaskBf16, Ord, true, false>(lds + RING_OFF, g, S, E, wave_s); }
                { const Ptrs p = kargs()->p; PHASE_TID(); rets_phase(p, p.QS - (size_t)MP * (2 * QKW + VW), 2 * QKW + VW, lds + RING_OFF, tid, wave, lane); }
                SEAM(base + S_MA);
            }
            if (IN(base + S_MB)) { const Ptrs p = kargs()->p; PHASE_TID(); ret_scan_phase(p, tid); SEAM(base + S_MB); }
            if (IN(base + S_MC)) { const Ptrs p = kargs()->p;
                pg8::Gemm g{512, 512, 512}; pg8::OrdRetOut S{G, (int)blockIdx.x, (const char*)p.A2, (const char*)p.B2}; pg8::EpiF32 E{p.ORET, VW, nullptr};
                pg8::gemm_phase<pg8::EpiF32, pg8::OrdRetOut, true, true>(lds + RING_OFF, g, S, E, wave_s);
                SEAM(base + S_MC);
            }
            if (IN(base + S_MD)) { const Ptrs p = kargs()->p; PHASE_TID(); ret_gate_phase(p, p.GB, VW, wave, lane); SEAM(base + S_MD); }
            if (IN(base + S_MOUT)) { const Ptrs p = kargs()->p;
                pg8::Gemm g{VW, VW, VW}; pg8::StaticOrder S; S.init(p.AOB, VW, p.wro_t, VW, M, D, G, (int)blockIdx.x);
                pg8::EpiF32 E{p.Y, D, nullptr};
                pg8::gemm_phase<pg8::EpiF32, pg8::StaticOrder, true, true>(lds + RING_OFF, g, S, E, wave_s);
                SEAM(base + S_MOUT);
            }
        } else {
            if (IN(base + S_MIN)) { const Ptrs p = kargs()->p;
                pg8::Gemm g{D, D, D}; pg8::StaticOrder S; S.init(p.XN, D, p.wai_t, D, M, NATT, G, (int)blockIdx.x);
                pg8::EpiBf16<0> E{p.QKV, NATT, nullptr, 0, 0, 1.f};
                pg8::gemm_phase<pg8::EpiBf16<0>, pg8::StaticOrder, true, true>(lds + RING_OFF, g, S, E, wave_s);
                SEAM(base + S_MIN);
            }
            if (IN(base + S_MA)) {
                { const Ptrs p = kargs()->p; PHASE_TID(); att::prompt_phase(p.QKV, p.OG, p.LSE, lds + RING_OFF, wave, lane); }
                { const Ptrs p = kargs()->p; PHASE_TID(); GRID_ITEMS((long)MS * NG * AH * (AD / 8), it_att(p, (long)MP * NG * AH * (AD / 8) + _i)); }
                { const Ptrs p = kargs()->p; PHASE_TID(); GRID_ITEMS(kv_out_total(), it_kv_out(p, _i)); }
                SEAM(base + S_MA);
            }
            if (IN(base + S_MB)) { const Ptrs p = kargs()->p; PHASE_TID(); GRID_ITEMS((long)M * AO, it_att_merge(p, _i)); SEAM(base + S_MB + 2); }
            if (IN(base + S_MOUT)) { const Ptrs p = kargs()->p;
                pg8::Gemm g{AO, AO, AO}; pg8::StaticOrder S; S.init(p.OB, AO, p.wao_t, AO, M, D, G, (int)blockIdx.x);
                pg8::EpiF32 E{p.Y, D, nullptr};
                pg8::gemm_phase<pg8::EpiF32, pg8::StaticOrder, true, true>(lds + RING_OFF, g, S, E, wave_s);
                SEAM(base + S_MOUT);
            }
        }
        if (IN(base + S_LNM)) { const Ptrs p = kargs()->p; PHASE_TID(); ln_rows_phase(p, L, 1, 1.0f, L, 2, wave, lane); SEAM(base + S_LNM); }
        if (IN(base + S_G1B)) { const Ptrs p = kargs()->p;
            pg8::Gemm g{D, D, D}; pg8::StaticOrder S; S.init(p.XN, D, p.wfi_t + (size_t)(L * 2 + 1) * NFF * D, D, M, NFF, G, (int)blockIdx.x);
            pg8::EpiSwiglu E{p.H, FF};
            pg8::gemm_phase<pg8::EpiSwiglu, pg8::StaticOrder, true, true>(lds + RING_OFF, g, S, E, wave_s);
            SEAM(base + S_G1B);
        }
        if (IN(base + S_G2B)) { const Ptrs p = kargs()->p;
            pg8::Gemm g{FF, FF, FF}; pg8::StaticOrder S; S.init(p.H, FF, p.wfo_t + (size_t)(L * 2 + 1) * D * FF, FF, M, D, G, (int)blockIdx.x);
            pg8::EpiF32 E{p.Y, D, nullptr};
            pg8::gemm_phase<pg8::EpiF32, pg8::StaticOrder, true, true>(lds + RING_OFF, g, S, E, wave_s);
            SEAM(base + S_G2B);
        }
        if (IN(base + S_LNB)) { const Ptrs p = kargs()->p; PHASE_TID(); ln_rows_phase(p, L, 2, 0.5f, L + 1, L == 0 ? 0 : -1, wave, lane); SEAM(base + S_LNB); }
    }
#undef IN
#undef SEAM
__global__ void __launch_bounds__(NT, 2) fwd(Args args) {
    using namespace cfg;
    extern __shared__ __attribute__((aligned(16))) unsigned char lds_raw[];
    LAS unsigned char* lds = (LAS unsigned char*)lds_raw;
    volatile LAS unsigned* MISC = (volatile LAS unsigned*)(lds + MISC_OFF);
    const int G = gridDim.x;
    const int wave_s = __builtin_amdgcn_readfirstlane((int)threadIdx.x >> 6);
    for (int u = TIDX(wave_s); u < (LDS_BYTES - LDSCTL_OFF) / 4; u += NT) ((LAS unsigned*)(lds + LDSCTL_OFF))[u] = 0u;
    __syncthreads();
    XcdBarrier bar; { unsigned* const ctl = kargs()->p.ctl; bar.bar = ctl + CW_BAR; bar.x = 0; bar.st = nullptr;
    if (MK_ONE_LAUNCH) bar = xcd_barrier_post(ctl + CW_BAR, MISC + 8, wave_s); }
    const int lo = args.ph_lo, hi = args.ph_hi;
#define IN(k) (lo <= (k) && (k) < hi)
#define SEAM(k) do { if (MK_ONE_LAUNCH && IN((k) + 1)) xcd_barrier(bar, wave_s); } while (0)

    if (IN(PH_PRO)) { const Ptrs p = kargs()->p; PHASE_TID(); p0_prologue(p, lds, tid, wave, lane); SEAM(PH_PRO); }
    if (IN(PH_ADA)) { const Ptrs p = kargs()->p;
        pg8::Gemm g{D, D, D}; pg8::StaticOrder S; S.init(p.sc, D, p.wada_t, D, SCR, 18 * D, G, (int)blockIdx.x);
        pg8::EpiF32 E{p.ada, ADA_LD, p.b_ada};
        pg8::gemm_phase<pg8::EpiF32, pg8::StaticOrder, true, true>(lds + RING_OFF, g, S, E, wave_s);
        SEAM(PH_ADA);
    }
    if (IN(PH_MOD0)) { const Ptrs p = kargs()->p; PHASE_TID(); GRID_ITEMS((long)M * D, it_mod0(p, _i)); SEAM(PH_MOD0); }

    layer_phases<0>(lds, bar, lo, hi, G, wave_s);
    layer_phases<1>(lds, bar, lo, hi, G, wave_s);
#undef IN
#undef SEAM
}

extern "C" void kernel_launch(void* const* d_in, const int* in_sizes, int n_in, void* d_out, int out_size, void* d_ws, size_t ws_size, hipStream_t stream) {
    using namespace cfg;
    static int grid = 0;
    if (grid == 0) {
        const long want_out = O_KV0 + kv_out_total();
        if (n_in != 20 || (long)out_size != want_out || ws_size < wsm::END) { fprintf(stderr, "kernel_launch: shape mismatch: n_in %d out %d (want %ld) ws %zu (want %zu); nothing launched\n", n_in, out_size, want_out, ws_size, (size_t)wsm::END); grid = -1; return; }
        int dev = 0, cus = 0, per_cu = 0;
        if (hipGetDevice(&dev) != hipSuccess || hipDeviceGetAttribute(&cus, hipDeviceAttributeMultiprocessorCount, dev) != hipSuccess) { grid = -1; return; }
        if (hipFuncSetAttribute((const void*)fwd, hipFuncAttributeMaxDynamicSharedMemorySize, LDS_BYTES) != hipSuccess) { fprintf(stderr, "kernel_launch: hipFuncSetAttribute failed\n"); grid = -1; return; }
        if (hipOccupancyMaxActiveBlocksPerMultiprocessor(&per_cu, (const void*)fwd, NT, LDS_BYTES) != hipSuccess || per_cu < 1) fprintf(stderr, "kernel_launch: note: occupancy query reports %d workgroups per CU\n", per_cu);
        (void)hipGetLastError();
        grid = cus;
    }
    if (grid < 0) return;
    unsigned char* ws = (unsigned char*)d_ws;
    if (hipMemsetAsync(ws + wsm::CTL, 0, wsm::CTL_BYTES, stream) != hipSuccess) return;
    Args a{};
    Ptrs& p = a.p; const float* const* in = (const float* const*)d_in;
    p.x_prompt = in[0]; p.x_sample = in[1]; p.c_prompt = in[2]; p.c_sample = in[3]; p.state_ret = in[4]; p.cache0 = in[5]; p.cache1 = in[6]; p.cache2 = in[7];
    p.w_ada = in[8]; p.b_ada = in[9]; p.ln_g = in[10]; p.ln_b = in[11]; p.w_ffn_in = in[12]; p.w_ffn_out = in[13]; p.w_ret_in = in[14]; p.ret_gn_g = in[15]; p.ret_gn_b = in[16];
    p.w_ret_out = in[17]; p.w_att_in = in[18]; p.w_att_out = in[19];
    p.out = (float*)d_out; p.ctl = (unsigned*)(ws + wsm::CTL);
    p.wfi_t = (bf16*)(ws + wsm::WFI); p.wfo_t = (bf16*)(ws + wsm::WFO); p.wri_t = (bf16*)(ws + wsm::WRI); p.wro_t = (bf16*)(ws + wsm::WRO); p.wai_t = (bf16*)(ws + wsm::WAI); p.wao_t = (bf16*)(ws + wsm::WAO);
    p.wada_t = (bf16*)(ws + wsm::WADA); p.sc = (bf16*)(ws + wsm::SC); p.ada = (float*)(ws + wsm::ADA); p.X = (float*)(ws + wsm::X); p.Y = (float*)(ws + wsm::Y);
    p.XN = (bf16*)(ws + wsm::XN); p.H = (bf16*)(ws + wsm::H); p.QKV = (bf16*)(ws + wsm::QKV); p.AOB = (bf16*)(ws + wsm::AOB); p.OB = (bf16*)(ws + wsm::OB);
    p.U = (float*)(ws + wsm::U); p.SIN = (float*)(ws + wsm::SIN); p.PS = (float*)(ws + wsm::PS); p.ORET = (float*)(ws + wsm::ORET); p.OG = (float*)(ws + wsm::OG); p.LSE = (float*)(ws + wsm::LSE);
    p.A2 = (bf16*)(ws + wsm::A2); p.B2 = (bf16*)(ws + wsm::B2); p.KB = (bf16*)(ws + wsm::KB); p.KT = (bf16*)(ws + wsm::KT); p.UT = (float*)(ws + wsm::UT); p.GB = (bf16*)(ws + wsm::GB); p.QS = (bf16*)(ws + wsm::QS);
#if MK_ONE_LAUNCH
    a.ph_lo = 0; a.ph_hi = NPH;
    hipLaunchKernelGGL(fwd, dim3(grid), dim3(NT), LDS_BYTES, stream, a);
#else
    for (int ph = 0; ph < NPH; ++ph) {
        const int s = ph >= PH_L0 ? (ph - PH_L0) % PH_PER_LAYER : -1, L = ph >= PH_L0 ? (ph - PH_L0) / PH_PER_LAYER : -1;
        if (L == 1 && (s == S_MC || s == S_MD)) continue;
        a.ph_lo = ph; a.ph_hi = ph + 1;
        hipLaunchKernelGGL(fwd, dim3(grid), dim3(NT), LDS_BYTES, stream, a);
    }
#endif
    const hipError_t le = hipPeekAtLastError();
    if (le != hipSuccess) fprintf(stderr, "kernel_launch: launch failed: %s\n", hipGetErrorName(le));
}

#endif
```
